# Optimizing an MI355X kernel written in HIP

```python
import math
import jax, jax.numpy as jnp
from jax import lax
import numpy as np

D_MODEL = 2048
BATCH = 1
SEQ = 16384
DEPTH = 4
DEC_BATCH = 2
DEC_SEQ = 4096
PAST_LEN = 128

PLE_DIM = 256
GRID_W = 64
HEAD_DIM = 128
EPS = 1e-6
Q_BLOCK = 128
NA_HEADS = 6
NA_WIN_ROWS = 8
NA_WIN_COLS = 16
MLA_HEADS = 5
MLA_Q_RANK = 512
MLA_KV_RANK = 256
MLA_NOPE_DIM = 128
MLA_ROPE_DIM = 64
MLA_V_DIM = 128
MLA_ROPE_THETA = 10000.0
DIFF_HEADS = 5
DIFF_QK_DIM = 64
DIFF_V_DIM = 128
ROPE_THETA = 500000.0
ROPE_PART_DIM = DIFF_QK_DIM // 4
D_FF = 5632
CONV_W = 3

NA_W = NA_HEADS * HEAD_DIM
MLA_QK_DIM = MLA_NOPE_DIM + MLA_ROPE_DIM
DIFF_QK_W = DIFF_HEADS * 2 * DIFF_QK_DIM
D_MIX = NA_W + MLA_HEADS * MLA_V_DIM + DIFF_HEADS * DIFF_V_DIM
_SIZES = (NA_W, NA_W, NA_W, MLA_Q_RANK, MLA_KV_RANK, MLA_ROPE_DIM,
          DIFF_QK_W, DIFF_QK_W, DIFF_HEADS * DIFF_V_DIM)
IN_COLS = sum(_SIZES)
SPLIT_POINTS = tuple(int(v) for v in np.cumsum(_SIZES)[:-1])

kernel_name = "hybrid_na_mla_diff_encoder"


def rms_norm(x, g):
    xf = x.astype(jnp.float32)
    y = xf * lax.rsqrt(jnp.mean(xf * xf, axis=-1, keepdims=True) + EPS)
    return (y * g.astype(jnp.float32)).astype(x.dtype)


def rope_angles(T, dim, theta):
    inv = 1.0 / (theta ** (jnp.arange(0, dim, 2, dtype=jnp.float32) / dim))
    ang = jnp.arange(T, dtype=jnp.float32)[:, None] * inv[None, :]
    return jnp.cos(ang), jnp.sin(ang)


def apply_rope(x, cos, sin):
    x1, x2 = jnp.split(x, 2, axis=-1)
    c = cos.astype(x.dtype)
    s = sin.astype(x.dtype)
    return jnp.concatenate([x1 * c - x2 * s, x1 * s + x2 * c], axis=-1)


def to_heads(u, n_heads):
    B, T, _ = u.shape
    return u.reshape(B, T, n_heads, -1).transpose(0, 2, 1, 3)


def from_heads(u):
    B, H, T, d = u.shape
    return u.transpose(0, 2, 1, 3).reshape(B, T, H * d)


def neighbourhood_attention(q, k, v, rpb):
    B, H, T, dh = q.shape
    rows = T // GRID_W
    kh = min(NA_WIN_ROWS, rows)
    kw = NA_WIN_COLS
    qg = q.reshape(B, H, rows, GRID_W, dh)
    kg = k.reshape(B, H, rows, GRID_W, dh)
    vg = v.reshape(B, H, rows, GRID_W, dh)
    cols = jnp.arange(GRID_W)
    col_start = jnp.clip(cols - kw // 2, 0, GRID_W - kw)
    col_idx = col_start[:, None] + jnp.arange(kw)[None, :]
    col_bias_idx = col_idx - cols[:, None] + (NA_WIN_COLS - 1)
    scale = dh ** -0.5

    def one_row(r):
        rs = jnp.clip(r - kh // 2, 0, rows - kh)
        k_rows = lax.dynamic_slice_in_dim(kg, rs, kh, axis=2)
        v_rows = lax.dynamic_slice_in_dim(vg, rs, kh, axis=2)
        k_win = k_rows[:, :, :, col_idx]
        v_win = v_rows[:, :, :, col_idx]
        q_r = lax.dynamic_index_in_dim(qg, r, axis=2, keepdims=False)
        s = jnp.einsum('bhcd,bhicjd->bhcij', q_r, k_win).astype(jnp.float32) * scale
        row_bias_idx = rs + jnp.arange(kh) - r + (NA_WIN_ROWS - 1)
        bias = rpb[:, row_bias_idx[None, :, None], col_bias_idx[:, None, :]]
        s = s + bias.astype(jnp.float32)[None]
        p = jax.nn.softmax(s.reshape(B, H, GRID_W, kh * kw), axis=-1)
        p = p.reshape(B, H, GRID_W, kh, kw).astype(v.dtype)
        return jnp.einsum('bhcij,bhicjd->bhcd', p, v_win)

    o = lax.map(one_row, jnp.arange(rows))
    return o.transpose(1, 2, 0, 3, 4).reshape(B, H, T, dh)


def dense_attention(q, k, v):
    B, H, T, dq = q.shape
    nb = T // Q_BLOCK
    qb = q.reshape(B, H, nb, Q_BLOCK, dq).transpose(2, 0, 1, 3, 4)
    scale = dq ** -0.5

    def one(qblk):
        s = jnp.einsum('bhqd,bhkd->bhqk', qblk, k).astype(jnp.float32) * scale
        p = jax.nn.softmax(s, axis=-1).astype(v.dtype)
        return jnp.einsum('bhqk,bhkd->bhqd', p, v)

    o = lax.map(one, qb)
    return o.transpose(1, 2, 0, 3, 4).reshape(B, H, T, v.shape[-1])


def differential_attention(q, k, v, lam):
    B, H, _, T, dq = q.shape
    nb = T // Q_BLOCK
    qb = q.reshape(B, H, 2, nb, Q_BLOCK, dq).transpose(3, 0, 1, 2, 4, 5)
    scale = dq ** -0.5

    def one(qblk):
        s = jnp.einsum('bhcqd,bhckd->bhcqk', qblk, k).astype(jnp.float32) * scale
        p = jax.nn.softmax(s, axis=-1)
        a = (p[:, :, 0] - lam * p[:, :, 1]).astype(v.dtype)
        return jnp.einsum('bhqk,bhkd->bhqd', a, v)

    o = lax.map(one, qb)
    return o.transpose(1, 2, 0, 3, 4).reshape(B, H, T, v.shape[-1])


def dwconv_centred(u, w, b):
    up = jnp.pad(u, ((0, 0), (1, 1), (0, 0)))
    return up[:, :-2] * w[0] + up[:, 1:-1] * w[1] + up[:, 2:] * w[2] + b


def encoder_layer(x, p_l, layer_idx, norm_mix, w_in, na_q_norm, na_k_norm, na_rpb,
                  mla_q_a_norm, mla_w_q_b, mla_kv_a_norm, mla_w_kv_b,
                  mla_q_nope_norm, mla_q_pe_norm, mla_k_nope_norm, mla_k_pe_norm,
                  diff_q_norm, diff_k_norm, diff_lambda_q1, diff_lambda_k1,
                  diff_lambda_q2, diff_lambda_k2, diff_subln, w_out,
                  norm_ffn, w_gate, w_up, conv_w, conv_b, w_down,
                  ple_norm, w_ple_gate, w_ple_proj):
    B, T, _ = x.shape
    h = rms_norm(x, norm_mix)
    proj = jnp.einsum('btd,dc->btc', h, w_in)
    (na_q, na_k, na_v, mla_cq, mla_ckv, mla_kpe,
     df_q, df_k, df_v) = jnp.split(proj, SPLIT_POINTS, axis=-1)

    qa = rms_norm(to_heads(na_q, NA_HEADS), na_q_norm)
    ka = rms_norm(to_heads(na_k, NA_HEADS), na_k_norm)
    va = to_heads(na_v, NA_HEADS)
    o_na = neighbourhood_attention(qa, ka, va, na_rpb)

    cos_m, sin_m = rope_angles(T, MLA_ROPE_DIM, MLA_ROPE_THETA)
    c_q = rms_norm(mla_cq, mla_q_a_norm)
    qm = to_heads(jnp.einsum('btr,rc->btc', c_q, mla_w_q_b), MLA_HEADS)
    q_nope = rms_norm(qm[..., :MLA_NOPE_DIM], mla_q_nope_norm)
    q_pe = apply_rope(rms_norm(qm[..., MLA_NOPE_DIM:], mla_q_pe_norm), cos_m, sin_m)
    c_kv = rms_norm(mla_ckv, mla_kv_a_norm)
    kv = to_heads(jnp.einsum('btr,rc->btc', c_kv, mla_w_kv_b), MLA_HEADS)
    k_nope = rms_norm(kv[..., :MLA_NOPE_DIM], mla_k_nope_norm)
    vm = kv[..., MLA_NOPE_DIM:]
    k_pe = apply_rope(rms_norm(mla_kpe, mla_k_pe_norm)[:, None], cos_m, sin_m)
    q_full = jnp.concatenate([q_nope, q_pe], axis=-1)
    k_full = jnp.concatenate([k_nope, jnp.broadcast_to(k_pe, (B, MLA_HEADS, T, MLA_ROPE_DIM))], axis=-1)
    o_mla = dense_attention(q_full, k_full, vm)

    cos_d, sin_d = rope_angles(T, ROPE_PART_DIM, ROPE_THETA)
    def diff_qk(u, g):
        u = u.reshape(B, T, DIFF_HEADS, 2, DIFF_QK_DIM).transpose(0, 2, 3, 1, 4)
        u = rms_norm(u, g)
        return jnp.concatenate([apply_rope(u[..., :ROPE_PART_DIM], cos_d, sin_d),
                                u[..., ROPE_PART_DIM:]], axis=-1)
    qd = diff_qk(df_q, diff_q_norm)
    kd = diff_qk(df_k, diff_k_norm)
    vd = to_heads(df_v, DIFF_HEADS)
    lam_init = 0.8 - 0.6 * math.exp(-0.3 * layer_idx)
    lam = (jnp.exp(jnp.sum(diff_lambda_q1.astype(jnp.float32) * diff_lambda_k1.astype(jnp.float32)))
           - jnp.exp(jnp.sum(diff_lambda_q2.astype(jnp.float32) * diff_lambda_k2.astype(jnp.float32)))
           + lam_init)
    o_df = differential_attention(qd, kd, vd, lam)
    o_df = rms_norm(o_df, diff_subln) * (1.0 - lam_init)

    mixed = jnp.concatenate([from_heads(o_na), from_heads(o_mla), from_heads(o_df)], axis=-1)
    x = x + jnp.einsum('btc,cd->btd', mixed, w_out)

    h = rms_norm(x, norm_ffn)
    g = dwconv_centred(jnp.einsum('btd,df->btf', h, w_gate), conv_w, conv_b)
    u = jnp.einsum('btd,df->btf', h, w_up)
    x = x + jnp.einsum('btf,fd->btd', jax.nn.silu(g) * u, w_down)

    gate = jax.nn.sigmoid(jnp.einsum('btd,de->bte', rms_norm(x, ple_norm), w_ple_gate))
    x = x + gate * jnp.einsum('btp,pd->btd', p_l, w_ple_proj)
    return x


def setup_inputs(seed: int = 0) -> dict:
    key = jax.random.key(seed)
    ks = iter(jax.random.split(key, 48))
    L = DEPTH

    def nrm(shape, scale):
        return scale * jax.random.normal(next(ks), shape, jnp.float32)

    def gain(shape):
        return 1.0 + nrm(shape, 0.02)

    return {
        "x_prompt": nrm((BATCH, SEQ, D_MODEL), 1.0),
        "x_sample": nrm((DEC_BATCH, DEC_SEQ, D_MODEL), 1.0),
        "p_prompt": nrm((DEPTH, BATCH, SEQ, PLE_DIM), 1.0),
        "p_sample": nrm((DEPTH, DEC_BATCH, DEC_SEQ, PLE_DIM), 1.0),
        "norm_mix": gain((L, D_MODEL)),
        "w_in": nrm((L, D_MODEL, IN_COLS), D_MODEL ** -0.5),
        "na_q_norm": gain((L, HEAD_DIM)),
        "na_k_norm": gain((L, HEAD_DIM)),
        "na_rpb": nrm((L, NA_HEADS, 2 * NA_WIN_ROWS - 1, 2 * NA_WIN_COLS - 1), 0.1),
        "mla_q_a_norm": gain((L, MLA_Q_RANK)),
        "mla_w_q_b": nrm((L, MLA_Q_RANK, MLA_HEADS * MLA_QK_DIM), MLA_Q_RANK ** -0.5),
        "mla_kv_a_norm": gain((L, MLA_KV_RANK)),
        "mla_w_kv_b": nrm((L, MLA_KV_RANK, MLA_HEADS * (MLA_NOPE_DIM + MLA_V_DIM)), MLA_KV_RANK ** -0.5),
        "mla_q_nope_norm": gain((L, MLA_NOPE_DIM)),
        "mla_q_pe_norm": gain((L, MLA_ROPE_DIM)),
        "mla_k_nope_norm": gain((L, MLA_NOPE_DIM)),
        "mla_k_pe_norm": gain((L, MLA_ROPE_DIM)),
        "diff_q_norm": gain((L, DIFF_QK_DIM)),
        "diff_k_norm": gain((L, DIFF_QK_DIM)),
        "diff_lambda_q1": nrm((L, DIFF_QK_DIM), 0.1),
        "diff_lambda_k1": nrm((L, DIFF_QK_DIM), 0.1),
        "diff_lambda_q2": nrm((L, DIFF_QK_DIM), 0.1),
        "diff_lambda_k2": nrm((L, DIFF_QK_DIM), 0.1),
        "diff_subln": gain((L, DIFF_V_DIM)),
        "w_out": nrm((L, D_MIX, D_MODEL), D_MIX ** -0.5),
        "norm_ffn": gain((L, D_MODEL)),
        "w_gate": nrm((L, D_MODEL, D_FF), D_MODEL ** -0.5),
        "w_up": nrm((L, D_MODEL, D_FF), D_MODEL ** -0.5),
        "conv_w": nrm((L, CONV_W, D_FF), CONV_W ** -0.5),
        "conv_b": nrm((L, D_FF), 0.01),
        "w_down": nrm((L, D_FF, D_MODEL), D_FF ** -0.5),
        "ple_norm": gain((L, D_MODEL)),
        "w_ple_gate": nrm((L, D_MODEL, D_MODEL), D_MODEL ** -0.5),
        "w_ple_proj": nrm((L, PLE_DIM, D_MODEL), PLE_DIM ** -0.5),
    }


def reference(x_prompt, x_sample, p_prompt, p_sample, norm_mix, w_in, na_q_norm, na_k_norm, na_rpb,
              mla_q_a_norm, mla_w_q_b, mla_kv_a_norm, mla_w_kv_b,
              mla_q_nope_norm, mla_q_pe_norm, mla_k_nope_norm, mla_k_pe_norm,
              diff_q_norm, diff_k_norm, diff_lambda_q1, diff_lambda_k1,
              diff_lambda_q2, diff_lambda_k2, diff_subln, w_out,
              norm_ffn, w_gate, w_up, conv_w, conv_b, w_down,
              ple_norm, w_ple_gate, w_ple_proj):
    y_prompt = x_prompt
    y_sample = x_sample
    for i in range(DEPTH):
        lw = (norm_mix[i], w_in[i], na_q_norm[i], na_k_norm[i], na_rpb[i],
              mla_q_a_norm[i], mla_w_q_b[i], mla_kv_a_norm[i], mla_w_kv_b[i],
              mla_q_nope_norm[i], mla_q_pe_norm[i], mla_k_nope_norm[i], mla_k_pe_norm[i],
              diff_q_norm[i], diff_k_norm[i], diff_lambda_q1[i], diff_lambda_k1[i],
              diff_lambda_q2[i], diff_lambda_k2[i], diff_subln[i], w_out[i],
              norm_ffn[i], w_gate[i], w_up[i], conv_w[i], conv_b[i], w_down[i],
              ple_norm[i], w_ple_gate[i], w_ple_proj[i])
        y_prompt = encoder_layer(y_prompt, p_prompt[i], i, *lw)
        y_sample = encoder_layer(y_sample, p_sample[i], i, *lw)
    return (y_prompt, y_sample)
```

```cpp
#include <hip/hip_runtime.h>
#include <cstdio>
#include <cstdint>
#include <cmath>
#include <utility>
#include <type_traits>

#ifndef PH_MASK
#define PH_MASK 0x3fff
#endif
#define PH_ON(k) (((PH_MASK) >> (k)) & 1)
#ifndef PROBE_MASK
#define PROBE_MASK 0
#endif
#define NREP(k) ((((PROBE_MASK) >> (k)) & 1) ? 2 : 1)
#ifndef MLA_PIPE
#define MLA_PIPE true
#endif
#ifndef CVT_AHEAD
#define CVT_AHEAD 1
#endif
#ifndef MK_SPLIT
#define MK_SPLIT 0
#endif

constexpr int DM = 2048, MROWS = 24576, NLAYER = 4, SEQ_P = 16384, SEQ_S = 4096;
constexpr int NPROJ = 5056, NPROJ_P = 5120, DFF = 5632, PLE = 256;
constexpr int C_NAQ = 0, C_NAK = 768, C_NAV = 1536, C_CQ = 2304, C_CKV = 2816, C_KPE = 3072, C_DFQ = 3136, C_DFK = 3776, C_DFV = 4416;
constexpr int LD_QM = 1024, LD_KVM = 1280, LD_KF = 960, LD_GU = 2 * DFF;
constexpr float EPS = 1e-6f;

typedef unsigned short bf16_t;
typedef short bf16x8 __attribute__((ext_vector_type(8)));
typedef short s16x4 __attribute__((ext_vector_type(4)));
typedef float f32x4 __attribute__((ext_vector_type(4)));
typedef float f32x2 __attribute__((ext_vector_type(2)));
typedef float f32x16 __attribute__((ext_vector_type(16)));
typedef unsigned u32x4 __attribute__((ext_vector_type(4)));
typedef unsigned u32x2 __attribute__((ext_vector_type(2)));

#define GAS __attribute__((address_space(1)))
#define LAS __attribute__((address_space(3)))

typedef __bf16 bf16x2_t __attribute__((ext_vector_type(2)));
__device__ __forceinline__ unsigned cvt_pk_bf16(float lo, float hi) { f32x2 v = {lo, hi}; bf16x2_t b = __builtin_convertvector(v, bf16x2_t); return __builtin_bit_cast(unsigned, b); }
__device__ __forceinline__ float bf_lo(unsigned w) { return __uint_as_float(w << 16); }
__device__ __forceinline__ float bf_hi(unsigned w) { return __uint_as_float(w & 0xffff0000u); }
__device__ __forceinline__ float bf2f(bf16_t h) { return __uint_as_float((unsigned)h << 16); }
__device__ __forceinline__ bf16_t f2bf(float f) { return (bf16_t)(cvt_pk_bf16(f, 0.f) & 0xffffu); }
__device__ __forceinline__ float sigm(float x) { return __builtin_amdgcn_rcpf(1.f + __builtin_amdgcn_exp2f(x * -1.4426950408889634f)); }
template <int X> __device__ __forceinline__ float swz_xor(float v) { return __int_as_float(__builtin_amdgcn_ds_swizzle(__float_as_int(v), (X << 10) | 0x1f)); }
__device__ __forceinline__ float xor32_sum(float v) { auto rr = __builtin_amdgcn_permlane32_swap(__float_as_uint(v), __float_as_uint(v), false, false); return __uint_as_float(rr[0]) + __uint_as_float(rr[1]); }
__device__ __forceinline__ float wsum32(float v) { v += swz_xor<1>(v); v += swz_xor<2>(v); v += swz_xor<4>(v); v += swz_xor<8>(v); v += swz_xor<16>(v); return v; }
__device__ __forceinline__ float wsum64(float v) { return xor32_sum(wsum32(v)); }
__device__ __forceinline__ int lane_id() { int l; asm volatile("v_mbcnt_lo_u32_b32 %0, -1, 0\n\tv_mbcnt_hi_u32_b32 %0, -1, %0" : "=v"(l)); return l; }
namespace pg8 {
constexpr int BM = 256, BK = 64, HALF = 128, HTB = HALF * BK * 2, STAGE_BYTES = 8 * HTB, NXCD = 8, WGM = 4;
__host__ __device__ __forceinline__ int lds_byte(int r, int c) { const int st = (r >> 4) * 2 + (c >> 5), rr = r & 15, cc = c & 31, ob = rr * 64 + cc * 2; return st * 1024 + (ob ^ (((ob >> 9) & 1) << 5)); }
__host__ __device__ __forceinline__ void stage_rc(int b, int& R, int& C) { const int st = b / 1024, sb = b % 1024, swz = sb ^ (((sb >> 9) & 1) << 5); R = (st >> 1) * 16 + swz / 64; C = (st & 1) * 32 + (swz % 64) / 2; }
__host__ __device__ __forceinline__ int perm32(int rho) { const int n = rho >> 4, i = rho & 15; return 8 * (i >> 2) + 4 * n + (i & 3); }

struct Unit { int pm, pn; };
struct Gemm { const bf16_t* A; const bf16_t* Bt; int M, N, K, lda; };

struct StaticOrder {
    int nM, nN, nwg, G, c;
    __device__ void init(int M, int N, int G_, int c_) { nM = M / BM; nN = N / BM; nwg = nM * nN; G = G_; c = c_; }
    __device__ bool next(int i, Unit& u) const {
        const long L = (long)i * G + c; if (L >= nwg) return false;
        int wgid = (int)L; { const int q = nwg / NXCD, r = nwg % NXCD, xcd = wgid % NXCD, off = wgid / NXCD; wgid = (xcd < r ? xcd * (q + 1) : r * (q + 1) + (xcd - r) * q) + off; }
        const int nig = WGM * nN, gid = wgid / nig, fm = gid * WGM, gsz = (nM - fm) < WGM ? (nM - fm) : WGM;
        u.pm = fm + ((wgid % nig) % gsz); u.pn = (wgid % nig) / gsz; return true;
    }
};

template <class Epi>
__device__ __forceinline__ void gemm_phase(LAS unsigned char* lds, const Gemm g, const StaticOrder& S, const Epi& E, int wave) {
    int lane_ = lane_id(); asm volatile("" : "+v"(lane_));
    const int wid = wave, lane = lane_, tid = wid * 64 + lane, wr = wid >> 2, wc = wid & 3, fr = lane & 15, fq = lane >> 4;
    const int K = g.K, nt = K / BK, lda = g.lda;
    unsigned voffA[2], voffB[2];
#pragma unroll
    for (int i = 0; i < 2; ++i) { int R, C; stage_rc(tid * 16 + i * 8192, R, C); const int Rb = (R & ~31) + perm32(R & 31);
        voffA[i] = (unsigned)(R * lda + C) * 2u; voffB[i] = (unsigned)(Rb * K + C) * 2u; }
    const size_t kstep = (size_t)(BK * 2);
    const size_t hstepA = (size_t)HALF * lda * 2, hstepB = (size_t)HALF * K * 2;
    const size_t tstepA = 2 * hstepA, tstepB = 2 * hstepB;
    const unsigned ldsw = (unsigned)wid * 1024u;
    const int aoff = lds_byte(wr * 64 + fr, fq * 8), boff = lds_byte(wc * 32 + fr, fq * 8);
#define PG8_SA(b, h) (((b) * 2 + (h)) * HTB)
#define PG8_SB(b, h) ((4 + (b) * 2 + (h)) * HTB)
#define PG8_STAGE(bufoff, gbase, voff) do { _Pragma("unroll") for (int _i = 0; _i < 2; ++_i) \
        __builtin_amdgcn_global_load_lds((const unsigned*)((const char*)(gbase) + (voff)[_i]), (LAS unsigned*)(lds + (bufoff) + ldsw + _i * 8192), 16, 0, 0); } while (0)
#define PG8_LDA(dst, b, h) do { _Pragma("unroll") for (int m = 0; m < 4; ++m) _Pragma("unroll") for (int k = 0; k < 2; ++k) dst[m][k] = *(const LAS bf16x8*)(lds + PG8_SA(b, h) + aoff + m * 2048 + k * 1024); } while (0)
#define PG8_LDB(dst, b, h) do { _Pragma("unroll") for (int n = 0; n < 2; ++n) _Pragma("unroll") for (int k = 0; k < 2; ++k) dst[n][k] = *(const LAS bf16x8*)(lds + PG8_SB(b, h) + boff + n * 2048 + k * 1024); } while (0)
#define PG8_MMA(ai, bj, At, Bt) do { __builtin_amdgcn_s_setprio(1); _Pragma("unroll") for (int m = 0; m < 4; ++m) _Pragma("unroll") for (int n = 0; n < 2; ++n) _Pragma("unroll") for (int k = 0; k < 2; ++k) \
        acc[ai][bj][m][n] = __builtin_amdgcn_mfma_f32_16x16x32_bf16(Bt[n][k], At[m][k], acc[ai][bj][m][n], 0, 0, 0); __builtin_amdgcn_s_setprio(0); } while (0)
#define PG8_WAIT_V(n) asm volatile("s_waitcnt vmcnt(" #n ")" ::: "memory")
#define PG8_WAIT_L(n) asm volatile("s_waitcnt lgkmcnt(" #n ")" ::: "memory")
#define PG8_BAR __builtin_amdgcn_s_barrier()
#define PG8_SCHED __builtin_amdgcn_sched_barrier(0)
    Unit cur, nxt; int ui = 0;
    if (!S.next(0, cur)) return;
    f32x4 acc[2][2][4][2];
#pragma unroll
    for (int a = 0; a < 2; ++a)
#pragma unroll
        for (int b = 0; b < 2; ++b)
#pragma unroll
            for (int m = 0; m < 4; ++m)
#pragma unroll
                for (int n = 0; n < 2; ++n) acc[a][b][m][n] = (f32x4){0.f, 0.f, 0.f, 0.f};
    bf16x8 At[4][2], B0[2][2], B1[2][2];
    const char* cA = (const char*)g.A + (size_t)cur.pm * tstepA; const char* cB = (const char*)g.Bt + (size_t)cur.pn * tstepB;
    PG8_STAGE(PG8_SB(0, 0), cB, voffB); PG8_STAGE(PG8_SB(0, 1), cB + hstepB, voffB); PG8_STAGE(PG8_SA(0, 0), cA, voffA); PG8_STAGE(PG8_SA(0, 1), cA + hstepA, voffA);
    if (wr == 1) PG8_BAR;
    PG8_WAIT_V(2); PG8_BAR;
    PG8_STAGE(PG8_SB(1, 0), cB + kstep, voffB); PG8_STAGE(PG8_SA(1, 0), cA + kstep, voffA); PG8_STAGE(PG8_SB(1, 1), cB + hstepB + kstep, voffB);
    PG8_WAIT_V(6); PG8_BAR;
    for (;;) {
        const bool has_next = S.next(ui + 1, nxt);
        const char* nA = has_next ? (const char*)g.A + (size_t)nxt.pm * tstepA : cA; const char* nB = has_next ? (const char*)g.Bt + (size_t)nxt.pn * tstepB : cB;
        for (int t = 0; t < nt; t += 2) {
            const bool last = (t == nt - 2);
            const char* a1 = cA + (size_t)(t + 1) * kstep;
            const char* a2 = last ? nA : cA + (size_t)(t + 2) * kstep; const char* b2 = last ? nB : cB + (size_t)(t + 2) * kstep;
            const char* a3 = a2 + kstep; const char* b3 = b2 + kstep;
            PG8_LDB(B0, 0, 0); PG8_LDB(B1, 0, 1); PG8_SCHED; PG8_LDA(At, 0, 0); PG8_STAGE(PG8_SA(1, 1), a1 + hstepA, voffA);
            PG8_WAIT_V(8); PG8_WAIT_L(0); PG8_BAR; PG8_MMA(0, 0, At, B0); PG8_MMA(0, 1, At, B1); PG8_BAR; PG8_SCHED;
            PG8_LDA(At, 0, 1); PG8_STAGE(PG8_SB(0, 0), b2, voffB); PG8_STAGE(PG8_SB(0, 1), b2 + hstepB, voffB); PG8_STAGE(PG8_SA(0, 0), a2, voffA);
            PG8_WAIT_V(8); PG8_WAIT_L(0); PG8_BAR; PG8_MMA(1, 0, At, B0); PG8_MMA(1, 1, At, B1); PG8_BAR; PG8_SCHED;
            PG8_LDB(B0, 1, 0); PG8_LDB(B1, 1, 1); PG8_SCHED; PG8_LDA(At, 1, 0); PG8_STAGE(PG8_SA(0, 1), a2 + hstepA, voffA);
            PG8_WAIT_V(8); PG8_WAIT_L(0); PG8_BAR; PG8_MMA(0, 0, At, B0); PG8_MMA(0, 1, At, B1); PG8_BAR; PG8_SCHED;
            PG8_LDA(At, 1, 1); PG8_STAGE(PG8_SB(1, 0), b3, voffB); PG8_STAGE(PG8_SB(1, 1), b3 + hstepB, voffB); PG8_STAGE(PG8_SA(1, 0), a3, voffA);
            PG8_WAIT_V(8); PG8_WAIT_L(0); PG8_BAR; PG8_MMA(1, 0, At, B0); PG8_MMA(1, 1, At, B1); PG8_BAR; PG8_SCHED;
        }
        if (wr == 0) PG8_BAR;
        E(acc, cur, wr, wc, fr, fq);
        if (!has_next) break;
#pragma unroll
        for (int a = 0; a < 2; ++a)
#pragma unroll
            for (int b = 0; b < 2; ++b)
#pragma unroll
                for (int m = 0; m < 4; ++m)
#pragma unroll
                    for (int n = 0; n < 2; ++n) acc[a][b][m][n] = (f32x4){0.f, 0.f, 0.f, 0.f};
        cur = nxt; cA = nA; cB = nB; ++ui;
        if (wr == 1) PG8_BAR;
    }
    PG8_WAIT_V(0);
    PG8_BAR;
#undef PG8_SA
#undef PG8_SB
#undef PG8_STAGE
#undef PG8_LDA
#undef PG8_LDB
#undef PG8_MMA
#undef PG8_WAIT_V
#undef PG8_WAIT_L
#undef PG8_BAR
#undef PG8_SCHED
}

__device__ __forceinline__ void load_rstd(const float* ss, int row_base, int fq, float (&rs)[2][4]) {
#pragma unroll
    for (int ai = 0; ai < 2; ++ai)
#pragma unroll
        for (int m = 0; m < 4; ++m) {
            const f32x4* p = (const f32x4*)(ss + (size_t)(row_base + ai * HALF + m * 16) * 32 + fq * 8);
            const f32x4 a = p[0], b = p[1];
            float s = ((a[0] + a[1]) + (a[2] + a[3])) + ((b[0] + b[1]) + (b[2] + b[3]));
            s += swz_xor<16>(s); s = xor32_sum(s);
            rs[ai][m] = rsqrtf(s * (1.0f / DM) + EPS);
        }
}
template <bool RS> struct EpiScaleBf16 {
    bf16_t* O; int ldc; const float* ss; float* ssq;
    __device__ __forceinline__ void operator()(const f32x4 (&acc)[2][2][4][2], const Unit& u, int wr, int wc, int fr, int fq) const {
        const int row0 = u.pm * BM + wr * 64 + fr, col0 = u.pn * BM + wc * 32 + 8 * fq;
        float rs[2][4];
        if (RS) load_rstd(ss, row0, fq, rs);
        const bool wsq = ssq != nullptr && u.pn >= 9 && u.pn < 12;
#pragma unroll
        for (int ai = 0; ai < 2; ++ai)
#pragma unroll
            for (int m = 0; m < 4; ++m) { bf16_t* rowp = O + (size_t)(row0 + ai * HALF + m * 16) * ldc + col0; const float sc = RS ? rs[ai][m] : 1.f;
                float sq = 0.f;
#pragma unroll
                for (int bj = 0; bj < 2; ++bj) { const f32x4 v0 = acc[ai][bj][m][0] * sc, v1 = acc[ai][bj][m][1] * sc;
                    u32x4 w; w.x = cvt_pk_bf16(v0[0], v0[1]); w.y = cvt_pk_bf16(v0[2], v0[3]); w.z = cvt_pk_bf16(v1[0], v1[1]); w.w = cvt_pk_bf16(v1[2], v1[3]);
                    *(u32x4*)(rowp + bj * HALF) = w;
                    if (wsq) sq += (v0[0] * v0[0] + v0[1] * v0[1]) + (v0[2] * v0[2] + v0[3] * v0[3]) + (v1[0] * v1[0] + v1[1] * v1[1]) + (v1[2] * v1[2] + v1[3] * v1[3]); }
                if (wsq) { sq += swz_xor<16>(sq); sq = xor32_sum(sq); if (fq == 0) ssq[(size_t)(row0 + ai * HALF + m * 16) * 16 + (u.pn - 9) * 4 + wc] = sq; } }
    }
};
template <int NP, int DIVN> struct EpiScaleLat {
    bf16_t* O; int ldc; const float* ssq;
    __device__ __forceinline__ void operator()(const f32x4 (&acc)[2][2][4][2], const Unit& u, int wr, int wc, int fr, int fq) const {
        const int l_ = lane_id(), fql = l_ >> 4;
        const int row0 = u.pm * BM + wr * 64 + (l_ & 15), col0 = u.pn * BM + wc * 32 + 8 * fql; (void)fr; (void)fq;
        float rs[2][4];
#pragma unroll
        for (int ai = 0; ai < 2; ++ai)
#pragma unroll
            for (int m = 0; m < 4; ++m) {
                const float* p = ssq + (size_t)(row0 + ai * HALF + m * 16) * 16 + fql * (NP / 4);
                float sq = p[0]; if (NP == 8) sq += p[1];
                sq += swz_xor<16>(sq); sq = xor32_sum(sq);
                rs[ai][m] = rsqrtf(sq * (1.0f / DIVN) + EPS);
            }
#pragma unroll
        for (int ai = 0; ai < 2; ++ai)
#pragma unroll
            for (int m = 0; m < 4; ++m) { bf16_t* rowp = O + (size_t)(row0 + ai * HALF + m * 16) * ldc + col0; const float sc = rs[ai][m];
#pragma unroll
                for (int bj = 0; bj < 2; ++bj) { const f32x4 v0 = acc[ai][bj][m][0] * sc, v1 = acc[ai][bj][m][1] * sc;
                    u32x4 w; w.x = cvt_pk_bf16(v0[0], v0[1]); w.y = cvt_pk_bf16(v0[2], v0[3]); w.z = cvt_pk_bf16(v1[0], v1[1]); w.w = cvt_pk_bf16(v1[2], v1[3]);
                    *(u32x4*)(rowp + bj * HALF) = w; } }
    }
};
struct EpiKvm {
    bf16_t* kvm; bf16_t* kf; const float* ssq; const float* g_kn; LAS float* xl;
    __device__ __forceinline__ void operator()(const f32x4 (&acc)[2][2][4][2], const Unit& u, int wr, int wc, int fr, int fq) const {
        const int l_ = lane_id(), fql = l_ >> 4, rowl = wr * 64 + (l_ & 15), colh = wc * 32 + 8 * fql; (void)fr; (void)fq;
        const int row0 = u.pm * BM + rowl;
        float rs[2][4];
#pragma unroll
        for (int ai = 0; ai < 2; ++ai)
#pragma unroll
            for (int m = 0; m < 4; ++m) {
                const float* p = ssq + (size_t)(row0 + ai * HALF + m * 16) * 16 + fql;
                float sq = p[0]; sq += swz_xor<16>(sq); sq = xor32_sum(sq);
                rs[ai][m] = rsqrtf(sq * (1.0f / 256.0f) + EPS);
            }
#pragma unroll
        for (int ai = 0; ai < 2; ++ai)
#pragma unroll
            for (int m = 0; m < 4; ++m) { const float sc = rs[ai][m];
                { const f32x4 v0 = acc[ai][1][m][0] * sc, v1 = acc[ai][1][m][1] * sc;
                  u32x4 w; w.x = cvt_pk_bf16(v0[0], v0[1]); w.y = cvt_pk_bf16(v0[2], v0[3]); w.z = cvt_pk_bf16(v1[0], v1[1]); w.w = cvt_pk_bf16(v1[2], v1[3]);
                  *(u32x4*)(kvm + (size_t)(row0 + ai * HALF + m * 16) * LD_KVM + u.pn * 256 + 128 + colh) = w; }
                const f32x4 k0 = acc[ai][0][m][0] * sc, k1 = acc[ai][0][m][1] * sc;
                float sq = (k0[0] * k0[0] + k0[1] * k0[1]) + (k0[2] * k0[2] + k0[3] * k0[3]) + (k1[0] * k1[0] + k1[1] * k1[1]) + (k1[2] * k1[2] + k1[3] * k1[3]);
                sq += swz_xor<16>(sq); sq = xor32_sum(sq);
                if (fql == 0) xl[(rowl + ai * HALF + m * 16) * 4 + wc] = sq; }
        asm volatile("s_waitcnt lgkmcnt(0)" ::: "memory"); __builtin_amdgcn_s_barrier(); asm volatile("" ::: "memory");
        const f32x4 g0 = *(const f32x4*)(g_kn + colh), g1 = *(const f32x4*)(g_kn + colh + 4);
#pragma unroll
        for (int ai = 0; ai < 2; ++ai)
#pragma unroll
            for (int m = 0; m < 4; ++m) { const f32x4 pp = *(const LAS f32x4*)(xl + (rowl + ai * HALF + m * 16) * 4);
                const float sc = rs[ai][m], rh = rsqrtf(((pp[0] + pp[1]) + (pp[2] + pp[3])) * (1.0f / 128.0f) + EPS);
                const f32x4 k0 = acc[ai][0][m][0] * sc * rh * g0, k1 = acc[ai][0][m][1] * sc * rh * g1;
                u32x4 w; w.x = cvt_pk_bf16(k0[0], k0[1]); w.y = cvt_pk_bf16(k0[2], k0[3]); w.z = cvt_pk_bf16(k1[0], k1[1]); w.w = cvt_pk_bf16(k1[2], k1[3]);
                *(u32x4*)(kf + (size_t)(row0 + ai * HALF + m * 16) * LD_KF + u.pn * 192 + colh) = w; }
    }
};
template <bool GATE> struct EpiResidual {
    const bf16_t* xin; float* xout; bf16_t* xbf; float* ss_out; const float* ss_in; const bf16_t* pp;
    __device__ __forceinline__ void operator()(const f32x4 (&acc)[2][2][4][2], const Unit& u, int wr, int wc, int fr, int fq) const {
        const int row0 = u.pm * BM + wr * 64 + fr, col0 = u.pn * BM + wc * 32 + 8 * fq;
        float rs[2][4];
        if (GATE) load_rstd(ss_in, row0, fq, rs);
#pragma unroll
        for (int ai = 0; ai < 2; ++ai)
#pragma unroll
            for (int m = 0; m < 4; ++m) {
                const int row = row0 + ai * HALF + m * 16;
                const size_t off = (size_t)row * DM + col0;
                float sq = 0.f;
#pragma unroll
                for (int bj = 0; bj < 2; ++bj) {
                    f32x4 d0 = acc[ai][bj][m][0], d1 = acc[ai][bj][m][1];
                    if (GATE) {
                        const u32x4 pw = *(const u32x4*)(pp + off + bj * HALF);
                        const float sc = rs[ai][m];
                        f32x4 p0 = {bf_lo(pw.x), bf_hi(pw.x), bf_lo(pw.y), bf_hi(pw.y)}, p1 = {bf_lo(pw.z), bf_hi(pw.z), bf_lo(pw.w), bf_hi(pw.w)};
#pragma unroll
                        for (int e = 0; e < 4; ++e) { d0[e] = p0[e] * sigm(d0[e] * sc); d1[e] = p1[e] * sigm(d1[e] * sc); }
                    }
                    const u32x4 xw = *(const u32x4*)(xin + off + bj * HALF);
                    const f32x4 x0 = {bf_lo(xw.x), bf_hi(xw.x), bf_lo(xw.y), bf_hi(xw.y)}, x1 = {bf_lo(xw.z), bf_hi(xw.z), bf_lo(xw.w), bf_hi(xw.w)};
                    const f32x4 o0 = x0 + d0, o1 = x1 + d1;
                    if (xout) { *(f32x4*)(xout + off + bj * HALF) = o0; *(f32x4*)(xout + off + bj * HALF + 4) = o1; }
                    u32x4 w; w.x = cvt_pk_bf16(o0[0], o0[1]); w.y = cvt_pk_bf16(o0[2], o0[3]); w.z = cvt_pk_bf16(o1[0], o1[1]); w.w = cvt_pk_bf16(o1[2], o1[3]);
                    *(u32x4*)(xbf + off + bj * HALF) = w;
                    sq += (o0[0] * o0[0] + o0[1] * o0[1]) + (o0[2] * o0[2] + o0[3] * o0[3]) + (o1[0] * o1[0] + o1[1] * o1[1]) + (o1[2] * o1[2] + o1[3] * o1[3]);
                }
                sq += swz_xor<16>(sq); sq = xor32_sum(sq);
                if (fq == 0) ss_out[(size_t)row * 32 + u.pn * 4 + wc] = sq;
            }
    }
};
struct EpiGateUp {
    bf16_t* act; const float* ss; const float* cw; const float* cb; LAS unsigned* xlds; float* edge;
    __device__ __forceinline__ void operator()(const f32x4 (&acc)[2][2][4][2], const Unit& u, int wr, int wc, int fr_, int fq_) const {
        int fr = fr_, fq = fq_; asm volatile("" : "+v"(fr), "+v"(fq));
        const int rl0 = wr * 64 + fr, cl = wc * 32 + 8 * fq, colF = u.pn * 128 + cl;
        float rs[2][4];
        load_rstd(ss, u.pm * BM + rl0, fq, rs);
        const int lane = fq * 16 + fr;
        const int iup = ((lane & 0x30) | ((lane - 1) & 15)) << 2, idn = ((lane & 0x30) | ((lane + 1) & 15)) << 2;
        { const int t = (wr * 4 + wc) * 64 + lane, arr = t >> 7, c = t & 127;
          ((LAS float*)xlds)[512 + t] = (arr < 3) ? cw[(size_t)arr * DFF + u.pn * 128 + c] : cb[u.pn * 128 + c]; }
#define LAUNDER(p) asm volatile("" : "+v"(p))
        GAS bf16_t* pa = (GAS bf16_t*)(act + (size_t)(u.pm * BM + rl0) * DFF + colF);
        unsigned gp[2][4][4];
#pragma unroll
        for (int ai = 0; ai < 2; ++ai)
#pragma unroll
            for (int m = 0; m < 4; ++m) { const f32x4 v0 = acc[ai][0][m][0] * rs[ai][m], v1 = acc[ai][0][m][1] * rs[ai][m];
                gp[ai][m][0] = cvt_pk_bf16(v0[0], v0[1]); gp[ai][m][1] = cvt_pk_bf16(v0[2], v0[3]); gp[ai][m][2] = cvt_pk_bf16(v1[0], v1[1]); gp[ai][m][3] = cvt_pk_bf16(v1[2], v1[3]); }
        if (fr == 0)  { *(LAS u32x4*)(xlds + ((0 * 2 + wr) * 2 + 0) * 64 + (cl >> 1)) = (u32x4){gp[0][0][0], gp[0][0][1], gp[0][0][2], gp[0][0][3]};
                        *(LAS u32x4*)(xlds + ((1 * 2 + wr) * 2 + 0) * 64 + (cl >> 1)) = (u32x4){gp[1][0][0], gp[1][0][1], gp[1][0][2], gp[1][0][3]}; }
        if (fr == 15) { *(LAS u32x4*)(xlds + ((0 * 2 + wr) * 2 + 1) * 64 + (cl >> 1)) = (u32x4){gp[0][3][0], gp[0][3][1], gp[0][3][2], gp[0][3][3]};
                        *(LAS u32x4*)(xlds + ((1 * 2 + wr) * 2 + 1) * 64 + (cl >> 1)) = (u32x4){gp[1][3][0], gp[1][3][1], gp[1][3][2], gp[1][3][3]}; }
        asm volatile("s_waitcnt lgkmcnt(0)" ::: "memory"); __builtin_amdgcn_s_barrier(); asm volatile("" ::: "memory");
#pragma unroll
        for (int ai = 0; ai < 2; ++ai) {
            const bool has_top = (wr == 1) || (ai == 1), has_bot = (wr == 0) || (ai == 0);
            const int tsel = (wr == 1) ? ((ai * 2 + 0) * 2 + 1) : ((0 * 2 + 1) * 2 + 1), bsel = (wr == 0) ? ((ai * 2 + 1) * 2 + 0) : ((1 * 2 + 0) * 2 + 0);
            const u32x4 z4 = {0u, 0u, 0u, 0u};
            const u32x4 topv = has_top ? *(const LAS u32x4*)(xlds + tsel * 64 + (cl >> 1)) : z4, botv = has_bot ? *(const LAS u32x4*)(xlds + bsel * 64 + (cl >> 1)) : z4;
            unsigned ur[4][4], dl[4][4];
#pragma unroll
            for (int m = 0; m < 4; ++m)
#pragma unroll
                for (int j = 0; j < 4; ++j) { ur[m][j] = (unsigned)__builtin_amdgcn_ds_bpermute(iup, (int)gp[ai][m][j]); dl[m][j] = (unsigned)__builtin_amdgcn_ds_bpermute(idn, (int)gp[ai][m][j]); }
            const bool e_first = (ai == 0 && wr == 0 && fr == 0), e_last = (ai == 1 && wr == 1 && fr == 15);
            float* const ep = edge + (size_t)(ai == 0 ? 0 : 3) * (96 * DFF) + (size_t)u.pm * DFF + colF;
#pragma unroll
            for (int m = 0; m < 4; ++m) {
                unsigned opk[4];
#pragma unroll
                for (int j = 0; j < 4; ++j) {
                    const unsigned upw = (fr > 0) ? ur[m][j] : (m > 0 ? ur[m > 0 ? m - 1 : 0][j] : topv[j]);
                    const unsigned dnw = (fr < 15) ? dl[m][j] : (m < 3 ? dl[m < 3 ? m + 1 : 3][j] : botv[j]);
                    const LAS f32x2* wl = (const LAS f32x2*)((const LAS float*)xlds + 512 + cl + 2 * j);
                    const f32x2 w0 = wl[0], w1 = wl[64], w2 = wl[128], bb = wl[192];
                    const float g0 = acc[ai][0][m][j >> 1][2 * (j & 1)] * rs[ai][m], g1 = acc[ai][0][m][j >> 1][2 * (j & 1) + 1] * rs[ai][m];
                    const float u0 = acc[ai][1][m][j >> 1][2 * (j & 1)] * rs[ai][m], u1 = acc[ai][1][m][j >> 1][2 * (j & 1) + 1] * rs[ai][m];
                    const float p0 = w1[0] * g0 + bb[0] + w0[0] * bf_lo(upw) + w2[0] * bf_lo(dnw), p1 = w1[1] * g1 + bb[1] + w0[1] * bf_hi(upw) + w2[1] * bf_hi(dnw);
                    opk[j] = cvt_pk_bf16(p0 * sigm(p0) * u0, p1 * sigm(p1) * u1);
                    if ((m == 0 && e_first) || (m == 3 && e_last)) { ep[2 * j] = p0; ep[2 * j + 1] = p1; ep[96 * DFF + 2 * j] = g0; ep[96 * DFF + 2 * j + 1] = g1; ep[2 * 96 * DFF + 2 * j] = u0; ep[2 * 96 * DFF + 2 * j + 1] = u1; }
                }
                if (!((m == 0 && e_first) || (m == 3 && e_last))) { u32x4 w; w.x = opk[0]; w.y = opk[1]; w.z = opk[2]; w.w = opk[3]; *(GAS u32x4*)pa = w; }
                pa += (size_t)(m == 3 ? 80 : 16) * DFF; LAUNDER(pa);
                __builtin_amdgcn_sched_barrier(0);
            }
        }
#undef LAUNDER
    }
};
}

namespace att {
constexpr int NW = 8, QBLK = 32, KVBLK = 64;
constexpr int SHM_V = 16384, OFF_V = 0, OFF_K = 49152, OFF_WS = 122880, ATT_LDS = 124928;
#define SBAR() __builtin_amdgcn_sched_barrier(0)
__device__ __forceinline__ int crow(int r, int hi) { return (r & 3) + 8 * (r >> 2) + 4 * hi; }
__device__ __forceinline__ void finishSM(f32x16& p0, f32x16& p1, float& l_reg, bf16x8& pa0, bf16x8& pa1, bf16x8& pa2, bf16x8& pa3) {
#pragma unroll
    for (int r = 0; r < 16; ++r) p0[r] = __builtin_amdgcn_exp2f(p0[r]);
#pragma unroll
    for (int r = 0; r < 16; ++r) p1[r] = __builtin_amdgcn_exp2f(p1[r]);
    float ps = 0;
#pragma unroll
    for (int r = 0; r < 16; ++r) ps += p0[r];
#pragma unroll
    for (int r = 0; r < 16; ++r) ps += p1[r];
    l_reg += ps;
#define PK4(P, BASE, OUT) do { unsigned a0 = cvt_pk_bf16(P[BASE + 0], P[BASE + 1]), a1 = cvt_pk_bf16(P[BASE + 2], P[BASE + 3]);   \
    unsigned b0 = cvt_pk_bf16(P[BASE + 4], P[BASE + 5]), b1 = cvt_pk_bf16(P[BASE + 6], P[BASE + 7]);                              \
    u32x4 w = {a0, a1, b0, b1}; OUT = *reinterpret_cast<bf16x8*>(&w); } while (0)
    PK4(p0, 0, pa0); PK4(p0, 8, pa1); PK4(p1, 0, pa2); PK4(p1, 8, pa3);
#undef PK4
}
template <int NQK> struct KB { static constexpr int NB = (NQK == 12) ? 4 : NQK; unsigned a[NB]; };
template <int NQK> __device__ __forceinline__ void kb_init(KB<NQK>& kb, unsigned k_lds_addr, int r32, int hi) {
    constexpr int NB = KB<NQK>::NB; const int f = (NQK == 8) ? (r32 & 15) : ((r32 >> 1) & 7);
#pragma unroll
    for (int k = 0; k < NB; ++k) kb.a[k] = k_lds_addr + (unsigned)(r32 * (NQK * 32) + (((2 * k + hi) ^ f) << 4));
}
__device__ __forceinline__ int v_rd_base(int lane) { return ((lane & 3) << 3) | (((lane >> 2) & 3) << 6) | (((lane >> 4) & 1) << 5) | (((lane >> 5) & 1) << 8); }
constexpr int v_rd_off(int d0, int ks, int half) { return d0 * 512 + ks * 4096 + half * 2048; }
struct NoHook { __device__ __forceinline__ void operator()(f32x16&, f32x16&, int, int) const {} };
struct NaHook {
    const LAS float* bias;
    int kr_lo, rq, rs, c, cs;
    __device__ __forceinline__ void operator()(f32x16& p0, f32x16& p1, int j, int hi) const {
        int t_ = 4 * hi - cs; asm volatile("" : "+v"(t_));
        float ninf; asm volatile("v_mov_b32 %0, 0xff800000" : "=v"(ninf));
        const int kr = kr_lo + j; const bool rowok = (kr >= rs) && (kr < rs + 8);
        const LAS float* bp = bias + ((kr - rq + 7) * 31 - c + 15 + 4 * hi);
#pragma unroll
        for (int r = 0; r < 16; ++r) {
            const int cj = (r & 3) + 8 * (r >> 2);
            const bool ok0 = rowok && ((unsigned)(t_ + cj) < 16u), ok1 = rowok && ((unsigned)(t_ + cj + 32) < 16u);
            const float b0 = bp[cj], b1 = bp[cj + 32];
            p0[r] = ok0 ? fmaf(b0, 1.4426950408889634f, p0[r]) : ninf;
            p1[r] = ok1 ? fmaf(b1, 1.4426950408889634f, p1[r]) : ninf;
        }
    }
};
__device__ __forceinline__ void q_unpack(const bf16x8& q, float (&v)[8]) { const u32x4 w = __builtin_bit_cast(u32x4, q);
    v[0] = bf_lo(w.x); v[1] = bf_hi(w.x); v[2] = bf_lo(w.y); v[3] = bf_hi(w.y); v[4] = bf_lo(w.z); v[5] = bf_hi(w.z); v[6] = bf_lo(w.w); v[7] = bf_hi(w.w); }
__device__ __forceinline__ bf16x8 q_pack(const float (&v)[8]) { const u32x4 w = {cvt_pk_bf16(v[0], v[1]), cvt_pk_bf16(v[2], v[3]), cvt_pk_bf16(v[4], v[5]), cvt_pk_bf16(v[6], v[7])}; return __builtin_bit_cast(bf16x8, w); }
template <int A, int B> __device__ __forceinline__ float q_rstd(const bf16x8* qr) {
    float ss = 0.f;
#pragma unroll
    for (int d0 = A; d0 < B; ++d0) { float v[8]; q_unpack(qr[d0], v);
#pragma unroll
        for (int e = 0; e < 8; ++e) ss = fmaf(v[e], v[e], ss); }
    return rsqrtf(xor32_sum(ss) * (1.0f / (16 * (B - A))) + EPS);
}
__device__ __forceinline__ void q_scale(float (&v)[8], float r, const float* g8, float scale) { const f32x4 g0 = *(const f32x4*)g8 * scale, g1 = *(const f32x4*)(g8 + 4) * scale;
#pragma unroll
    for (int e = 0; e < 4; ++e) { v[e] = v[e] * r * g0[e]; v[e + 4] = v[e + 4] * r * g1[e]; } }
#define QL(x) asm volatile("" : "+v"(x))
#define QDEP(dep, q) do { const unsigned w_ = __builtin_bit_cast(u32x4, q).x; asm volatile("" : "+v"(dep) : "v"(w_)); } while (0)
struct QNone { __device__ __forceinline__ void operator()(bf16x8*, int, int) const {} };
struct QNormNA {
    const float* g; float scale;
    __device__ __forceinline__ void operator()(bf16x8* qr, int, int hi) const {
        const float r = q_rstd<0, 8>(qr); int dep = 0;
#pragma unroll
        for (int d0 = 0; d0 < 8; ++d0) QL(qr[d0]);
#pragma unroll
        for (int d0 = 0; d0 < 8; ++d0) { float v[8]; q_unpack(qr[d0], v); q_scale(v, r, g + 16 * d0 + 8 * hi + dep, scale); qr[d0] = q_pack(v); QDEP(dep, qr[d0]); }
    }
};
struct QNormDiff {
    const float *g, *cosd, *sind; float scale;
    __device__ __forceinline__ void operator()(bf16x8* qr, int trow, int hi) const {
        const float r = q_rstd<0, 4>(qr); int dep = 0;
#pragma unroll
        for (int d0 = 0; d0 < 4; ++d0) QL(qr[d0]);
#pragma unroll
        for (int d0 = 0; d0 < 4; ++d0) { float v[8]; q_unpack(qr[d0], v); q_scale(v, r, g + 16 * d0 + 8 * hi + dep, scale);
            if (d0 == 0) { const f32x4 c0 = *(const f32x4*)(cosd + trow * 8), c1 = *(const f32x4*)(cosd + trow * 8 + 4), s0 = *(const f32x4*)(sind + trow * 8), s1 = *(const f32x4*)(sind + trow * 8 + 4);
#pragma unroll
                for (int e = 0; e < 8; ++e) { const float c = e < 4 ? c0[e & 3] : c1[e & 3], sn = e < 4 ? s0[e & 3] : s1[e & 3];
                    auto rr = __builtin_amdgcn_permlane32_swap(__float_as_uint(v[e]), __float_as_uint(v[e]), false, false);
                    const float p = __uint_as_float(hi ? rr[0] : rr[1]);
                    v[e] = hi ? (p * sn + v[e] * c) : (v[e] * c - p * sn); } }
            qr[d0] = q_pack(v); QDEP(dep, qr[d0]); }
    }
};
struct QNormMLA {
    const float *gn, *gp, *cosm, *sinm; float scale;
    __device__ __forceinline__ void operator()(bf16x8* qr, int trow, int hi) const {
        const float ra = q_rstd<0, 8>(qr), rb = q_rstd<8, 12>(qr); int dep = 0;
#pragma unroll
        for (int d0 = 0; d0 < 12; ++d0) QL(qr[d0]);
#pragma unroll
        for (int d0 = 0; d0 < 8; ++d0) { float v[8]; q_unpack(qr[d0], v); q_scale(v, ra, gn + 16 * d0 + 8 * hi + dep, scale); qr[d0] = q_pack(v); QDEP(dep, qr[d0]); }
#pragma unroll
        for (int k = 0; k < 2; ++k) { float a[8], b[8]; q_unpack(qr[8 + k], a); q_unpack(qr[10 + k], b);
            q_scale(a, rb, gp + 16 * k + 8 * hi + dep, scale); q_scale(b, rb, gp + 32 + 16 * k + 8 * hi + dep, scale);
            const float* cp = cosm + trow * 32 + 16 * k + 8 * hi + dep; const float* sp = sinm + trow * 32 + 16 * k + 8 * hi + dep;
            const f32x4 c0 = *(const f32x4*)cp, c1 = *(const f32x4*)(cp + 4), s0 = *(const f32x4*)sp, s1 = *(const f32x4*)(sp + 4);
#pragma unroll
            for (int e = 0; e < 8; ++e) { const float c = e < 4 ? c0[e & 3] : c1[e & 3], sn = e < 4 ? s0[e & 3] : s1[e & 3];
                const float x = a[e], y = b[e]; a[e] = x * c - y * sn; b[e] = x * sn + y * c; }
            qr[8 + k] = q_pack(a); qr[10 + k] = q_pack(b); QDEP(dep, qr[10 + k]); }
    }
};
#undef QL
#undef QDEP
struct AttnOut { bf16_t* dst; float* scr; float lam; const float* subln; float post; };

template <int I, int N, class F> __device__ __forceinline__ void static_for(F&& f) { if constexpr (I < N) { f(std::integral_constant<int, I>{}); static_for<I + 1, N>(f); } }
template <int OFF> __device__ __forceinline__ bf16x8 dsr128(unsigned a) { bf16x8 r; asm volatile("ds_read_b128 %0, %1 offset:%2" : "=&v"(r) : "v"(a), "i"(OFF) : "memory"); return r; }
template <int OFF> __device__ __forceinline__ s16x4 dstr(unsigned a) { s16x4 r; asm volatile("ds_read_b64_tr_b16 %0, %1 offset:%2" : "=&v"(r) : "v"(a), "i"(OFF) : "memory"); return r; }
template <int N> __device__ __forceinline__ void lgk_wait() { asm volatile("s_waitcnt lgkmcnt(%0)" :: "i"(N) : "memory"); }
template <int NQK, bool DO_QK, bool DO_PV, bool PRE>
__device__ __forceinline__ void mseg(f32x16& S0, f32x16& S1, f32x16* o, const KB<NQK>& kb, int kbufoff, const bf16x8* qr, unsigned vb, bf16x8 pa0, bf16x8 pa1, bf16x8 pa2, bf16x8 pa3, bf16x8 (&kfa)[4]) {
    constexpr int NB = KB<NQK>::NB, NG = NQK / 2, RB = NQK * 32;
    constexpr int NKS = DO_QK ? NG : 0, NVS = DO_PV ? 4 : 0, NST = NKS + NVS;
    bf16x8 kfb[4], kfc[4]; s16x4 vf[3][8];
    unsigned ka[NB];
    if constexpr (DO_QK) {
#pragma unroll
        for (int k = 0; k < NB; ++k) ka[k] = kb.a[k] + (unsigned)kbufoff;
        S0 = f32x16{}; S1 = f32x16{};
    }
    auto issue = [&](auto st) {
        constexpr int ST = decltype(st)::value;
        if constexpr (ST < NKS) {
            constexpr int G = ST, SET = G % 3;
            static_for<0, 2>([&](auto s_) { constexpr int D0 = 2 * G + decltype(s_)::value, SS = decltype(s_)::value;
                const bf16x8 r0 = dsr128<(D0 / NB) * 128>(ka[D0 % NB]), r1 = dsr128<(D0 / NB) * 128 + 32 * RB>(ka[D0 % NB]);
                if constexpr (SET == 0) { kfa[2 * SS] = r0; kfa[2 * SS + 1] = r1; } else if constexpr (SET == 1) { kfb[2 * SS] = r0; kfb[2 * SS + 1] = r1; } else { kfc[2 * SS] = r0; kfc[2 * SS + 1] = r1; } });
        } else {
            constexpr int D0 = ST - NKS, SET = D0 % 3;
            static_for<0, 4>([&](auto ks_) { constexpr int KS = decltype(ks_)::value;
                vf[SET][2 * KS] = dstr<v_rd_off(D0, KS, 0)>(vb); vf[SET][2 * KS + 1] = dstr<v_rd_off(D0, KS, 1)>(vb); });
        }
    };
#define STCNT(st) (((st) >= NST) ? 0 : ((st) < NKS ? 4 : 8))
    if constexpr (!(PRE && DO_QK)) issue(std::integral_constant<int, 0>{});
    if constexpr (NST > 1) issue(std::integral_constant<int, 1>{});
    static_for<0, NST>([&](auto st) {
        constexpr int ST = decltype(st)::value;
        if constexpr (ST + 2 < NST) issue(std::integral_constant<int, ST + 2>{});
        { constexpr int AHEAD = STCNT(ST + 1) + STCNT(ST + 2); lgk_wait<(AHEAD > 15 ? 15 : AHEAD)>(); }
        SBAR();
        if constexpr (ST < NKS) {
            constexpr int G = ST, SET = G % 3;
            static_for<0, 2>([&](auto s_) { constexpr int SS = decltype(s_)::value;
                if constexpr (SET == 0) { S0 = __builtin_amdgcn_mfma_f32_32x32x16_bf16(kfa[2 * SS], qr[2 * G + SS], S0, 0, 0, 0); S1 = __builtin_amdgcn_mfma_f32_32x32x16_bf16(kfa[2 * SS + 1], qr[2 * G + SS], S1, 0, 0, 0); }
                else if constexpr (SET == 1) { S0 = __builtin_amdgcn_mfma_f32_32x32x16_bf16(kfb[2 * SS], qr[2 * G + SS], S0, 0, 0, 0); S1 = __builtin_amdgcn_mfma_f32_32x32x16_bf16(kfb[2 * SS + 1], qr[2 * G + SS], S1, 0, 0, 0); }
                else { S0 = __builtin_amdgcn_mfma_f32_32x32x16_bf16(kfc[2 * SS], qr[2 * G + SS], S0, 0, 0, 0); S1 = __builtin_amdgcn_mfma_f32_32x32x16_bf16(kfc[2 * SS + 1], qr[2 * G + SS], S1, 0, 0, 0); } });
        } else {
            constexpr int D0 = ST - NKS, SET = D0 % 3;
#define VPK(ks) (bf16x8){vf[SET][2 * (ks)][0], vf[SET][2 * (ks)][1], vf[SET][2 * (ks)][2], vf[SET][2 * (ks)][3], vf[SET][2 * (ks) + 1][0], vf[SET][2 * (ks) + 1][1], vf[SET][2 * (ks) + 1][2], vf[SET][2 * (ks) + 1][3]}
            o[D0] = __builtin_amdgcn_mfma_f32_32x32x16_bf16(VPK(0), pa0, o[D0], 0, 0, 0);
            o[D0] = __builtin_amdgcn_mfma_f32_32x32x16_bf16(VPK(1), pa1, o[D0], 0, 0, 0);
            o[D0] = __builtin_amdgcn_mfma_f32_32x32x16_bf16(VPK(2), pa2, o[D0], 0, 0, 0);
            o[D0] = __builtin_amdgcn_mfma_f32_32x32x16_bf16(VPK(3), pa3, o[D0], 0, 0, 0);
#undef VPK
        }
    });
#undef STCNT
}

template <int NQK> __device__ __forceinline__ void kpre(bf16x8 (&kfa)[4], const KB<NQK>& kb, int kbufoff) {
    constexpr int NB = KB<NQK>::NB, RB = NQK * 32;
    static_for<0, 2>([&](auto s_) { constexpr int D0 = decltype(s_)::value; const unsigned ad = kb.a[D0 % NB] + (unsigned)kbufoff;
        kfa[2 * D0] = dsr128<(D0 / NB) * 128>(ad); kfa[2 * D0 + 1] = dsr128<(D0 / NB) * 128 + 32 * RB>(ad); });
}

template <int NQK, int MODE, int ldq, int ldk, int ldv, int LDO, class Hook, class QP>
__device__ __forceinline__ void attn_pp(const bf16_t* __restrict__ Qb, const bf16_t* __restrict__ Kh, const bf16_t* __restrict__ Vh,
                                        int NT, char* lds, const Hook& hook, const AttnOut& out, int wave, const QP& qprep, int t0) {
    constexpr int RB = NQK * 32, KT = 64 * RB, NKP = KT / 4096, NOG = NKP > 4 ? NKP : 4;
    int lane_ = lane_id(); asm volatile("" : "+v"(lane_));
    const int wid = wave, lane = lane_, r32 = lane & 31, hi = lane >> 5, g = wave >> 2, gi = wave & 3;
    char* V_lds = lds + OFF_V; char* K_lds = lds + OFF_K;
    float l_reg = 0; f32x16 o[4] = {}; bf16x8 qr[NQK];
    { const bf16_t* Qw = Qb + (long)(wid * QBLK + r32) * ldq + hi * 8;
#pragma unroll
      for (int d0 = 0; d0 < NQK; ++d0) qr[d0] = *reinterpret_cast<const bf16x8*>(Qw + d0 * 16);
      qprep(qr, t0 + wid * QBLK + r32, hi); }
    unsigned og[NOG];
    if (g == 1) {
#pragma unroll
        for (int i = 0; i < NKP; ++i) { const int off = (gi * NKP + i) * 1024 + lane * 16, row = off / RB, ph = (off % RB) >> 4, f = (NQK == 8) ? (row & 15) : ((row >> 1) & 7);
            og[i] = (unsigned)(row * ldk + (ph ^ f) * 8) * 2u; }
#pragma unroll
        for (int i = NKP; i < NOG; ++i) og[i] = 0u;
    } else {
#pragma unroll
        for (int i = 0; i < 4; ++i) { const int off = (gi * 4 + i) * 1024 + lane * 16, sub = off >> 9, within = (off & 511) >> 1, kk = (sub >> 2) * 8 + (within >> 5), c = (sub & 3) * 32 + (within & 31);
            const int k = kk;
            og[i] = (unsigned)(k * ldv + c) * 2u; }
#pragma unroll
        for (int i = 4; i < NOG; ++i) og[i] = 0u;
    }
    const int vb0 = (int)(uintptr_t)V_lds + v_rd_base(lane);
    KB<NQK> kb; kb_init<NQK>(kb, (unsigned)(uintptr_t)K_lds, r32, hi);
    LAS unsigned char* const kdst = (LAS unsigned char*)(uintptr_t)((unsigned)(uintptr_t)K_lds + (unsigned)(gi * NKP) * 1024u);
    LAS unsigned char* const vdst = (LAS unsigned char*)(uintptr_t)((unsigned)(uintptr_t)V_lds + (unsigned)(gi * 4) * 1024u);
#define DMA_K(t, b) do { const char* kt_ = (const char*)(Kh + (long)(t) * (KVBLK * ldk)); _Pragma("unroll") for (int i_ = 0; i_ < NKP; ++i_) \
    __builtin_amdgcn_global_load_lds((const unsigned*)(kt_ + og[i_]), (LAS unsigned*)(kdst + (b) * KT + i_ * 1024), 16, 0, 0); } while (0)
#define DMA_V(t, b) do { const char* vt_ = (const char*)(Vh + (long)(t) * (KVBLK * ldv)); _Pragma("unroll") for (int i_ = 0; i_ < 4; ++i_) \
    __builtin_amdgcn_global_load_lds((const unsigned*)(vt_ + og[i_]), (LAS unsigned*)(vdst + (b) * SHM_V + i_ * 1024), 16, 0, 0); } while (0)
#define VMW() asm volatile("s_waitcnt vmcnt(0)" ::: "memory")
#define PBAR() do { asm volatile("s_waitcnt lgkmcnt(0)" ::: "memory"); __builtin_amdgcn_s_barrier(); asm volatile("" ::: "memory"); SBAR(); } while (0)
    f32x16 S0, S1; bf16x8 pa0, pa1, pa2, pa3, kfa[4];
    if (g == 0) DMA_V(0, 0); else { DMA_K(0, 0); DMA_K(1, 1); }
    VMW(); PBAR();
    const unsigned vbu = (unsigned)vb0;
    if (g == 0) {
        mseg<NQK, true, false, false>(S0, S1, o, kb, 0, qr, vbu, pa0, pa1, pa2, pa3, kfa); PBAR();
        int vcur = 0, vnext = 1, kn = 1;
        for (int t = 0; t + 1 < NT; ++t) {
            VMW(); DMA_V(t + 1, vnext);
            hook(S0, S1, t, hi); finishSM(S0, S1, l_reg, pa0, pa1, pa2, pa3); kpre<NQK>(kfa, kb, kn * KT); PBAR();
            mseg<NQK, true, true, true>(S0, S1, o, kb, kn * KT, qr, vbu + vcur * SHM_V, pa0, pa1, pa2, pa3, kfa); PBAR();
            vcur = vnext; vnext = (vnext == 2) ? 0 : vnext + 1; kn = (kn == 2) ? 0 : kn + 1;
        }
        VMW(); hook(S0, S1, NT - 1, hi); finishSM(S0, S1, l_reg, pa0, pa1, pa2, pa3); PBAR();
        mseg<NQK, false, true, false>(S0, S1, o, kb, 0, qr, vbu + vcur * SHM_V, pa0, pa1, pa2, pa3, kfa); PBAR();
        PBAR();
    } else {
        if (2 < NT) DMA_K(2, 2); PBAR();
        mseg<NQK, true, false, false>(S0, S1, o, kb, 0, qr, vbu, pa0, pa1, pa2, pa3, kfa); VMW(); PBAR();
        int vcur = 0, kn = 1, kd = 0;
        for (int t = 0; t + 1 < NT; ++t) {
            if (t + 3 < NT) DMA_K(t + 3, kd);
            hook(S0, S1, t, hi); finishSM(S0, S1, l_reg, pa0, pa1, pa2, pa3); kpre<NQK>(kfa, kb, kn * KT); PBAR();
            mseg<NQK, true, true, true>(S0, S1, o, kb, kn * KT, qr, vbu + vcur * SHM_V, pa0, pa1, pa2, pa3, kfa); VMW(); PBAR();
            vcur = (vcur == 2) ? 0 : vcur + 1; kn = (kn == 2) ? 0 : kn + 1; kd = (kd == 2) ? 0 : kd + 1;
        }
        hook(S0, S1, NT - 1, hi); finishSM(S0, S1, l_reg, pa0, pa1, pa2, pa3); PBAR();
        mseg<NQK, false, true, false>(S0, S1, o, kb, 0, qr, vbu + vcur * SHM_V, pa0, pa1, pa2, pa3, kfa); PBAR();
    }
#undef DMA_K
#undef DMA_V
#undef VMW
#undef PBAR
    { auto rr = __builtin_amdgcn_permlane32_swap(__float_as_uint(l_reg), __float_as_uint(l_reg), false, false); l_reg = __uint_as_float(rr[0]) + __uint_as_float(rr[1]); }
    const int lane_e = lane_id(), r32_e = lane_e & 31, hi_e = lane_e >> 5, tid_e = wid * 64 + lane_e;
    const float rl = 1.0f / l_reg;
#define LAUNDER(p) asm volatile("" : "+v"(p))
#define ST8(P, X0, X1, X2, X3, Y0, Y1, Y2, Y3) do { const unsigned a0_ = cvt_pk_bf16(X0, X1), a1_ = cvt_pk_bf16(X2, X3), b0_ = cvt_pk_bf16(Y0, Y1), b1_ = cvt_pk_bf16(Y2, Y3);   \
        auto s0_ = __builtin_amdgcn_permlane32_swap(a0_, b0_, false, false); auto s1_ = __builtin_amdgcn_permlane32_swap(a1_, b1_, false, false);                       \
        u32x4 w_ = {s0_[0], s1_[0], s0_[1], s1_[1]}; *(GAS u32x4*)(P) = w_; } while (0)
    if constexpr (MODE == 0) {
        GAS bf16_t* p = (GAS bf16_t*)(out.dst + (long)(wid * QBLK + r32_e) * LDO + 8 * hi_e);
#pragma unroll
        for (int d0 = 0; d0 < 4; ++d0) {
#pragma unroll
            for (int j = 0; j < 2; ++j)
                ST8(p + d0 * 32 + 16 * j, o[d0][8 * j] * rl, o[d0][8 * j + 1] * rl, o[d0][8 * j + 2] * rl, o[d0][8 * j + 3] * rl, o[d0][8 * j + 4] * rl, o[d0][8 * j + 5] * rl, o[d0][8 * j + 6] * rl, o[d0][8 * j + 7] * rl);
        }
    } else if constexpr (MODE == 1) {
        GAS f32x4* sp = (GAS f32x4*)out.scr + tid_e;
#pragma unroll
        for (int d0 = 0; d0 < 4; ++d0) {
#pragma unroll
            for (int q4 = 0; q4 < 4; ++q4) { f32x4 v = {o[d0][4 * q4] * rl, o[d0][4 * q4 + 1] * rl, o[d0][4 * q4 + 2] * rl, o[d0][4 * q4 + 3] * rl}; sp[(d0 * 4 + q4) * 512] = v; }
        }
    } else {
        GAS bf16_t* p = (GAS bf16_t*)(out.dst + (long)(wid * QBLK + r32_e) * LDO + 8 * hi_e);
        const GAS f32x4* sp = (const GAS f32x4*)out.scr + tid_e;
        const float nl = -out.lam * rl;
        float sq = 0.f;
#pragma unroll
        for (int d0 = 0; d0 < 4; ++d0) {
#pragma unroll
            for (int q4 = 0; q4 < 4; ++q4) { const f32x4 c0 = sp[(d0 * 4 + q4) * 512];
#pragma unroll
                for (int e = 0; e < 4; ++e) { const float v = fmaf(nl, o[d0][4 * q4 + e], c0[e]); o[d0][4 * q4 + e] = v; sq = fmaf(v, v, sq); } }
        }
        sq = xor32_sum(sq);
        const float rs = rsqrtf(sq * (1.0f / 128.0f) + EPS) * out.post;
        const GAS f32x4* gp = (const GAS f32x4*)(out.subln + 4 * hi_e);
#pragma unroll
        for (int d0 = 0; d0 < 4; ++d0) {
#pragma unroll
            for (int j = 0; j < 2; ++j) { const f32x4 g0 = gp[d0 * 8 + 4 * j], g1 = gp[d0 * 8 + 4 * j + 2];
                ST8(p + d0 * 32 + 16 * j, o[d0][8 * j] * rs * g0[0], o[d0][8 * j + 1] * rs * g0[1], o[d0][8 * j + 2] * rs * g0[2], o[d0][8 * j + 3] * rs * g0[3],
                    o[d0][8 * j + 4] * rs * g1[0], o[d0][8 * j + 5] * rs * g1[1], o[d0][8 * j + 6] * rs * g1[2], o[d0][8 * j + 7] * rs * g1[3]); }
        }
    }
#undef ST8
#undef LAUNDER
}
#undef SBAR
}

constexpr size_t MiB = 1u << 20;
constexpr size_t WS_CTL = 0, CTL_ZERO_BYTES = 1 * MiB;
constexpr size_t WS_COSM = 1 * MiB, WS_SINM = 3 * MiB, WS_COSD = 5 * MiB, WS_SIND = 5 * MiB + 512 * 1024;
constexpr size_t WS_SSA = 8 * MiB, WS_SSB = 11 * MiB, WS_SSQ = 14 * MiB;
constexpr size_t WS_WIN = 16 * MiB, WS_WQB = 36 * MiB, WS_WKVB = 37 * MiB, WS_WOUT = 38 * MiB, WS_WGU = 46 * MiB, WS_WDN = 90 * MiB, WS_WPG = 112 * MiB, WS_WPP = 120 * MiB, WS_PB = 121 * MiB;
constexpr size_t WS_XB = 134 * MiB;
constexpr size_t WS_BIG = 230 * MiB;
constexpr size_t WS_PROJ = WS_BIG, WS_QM = WS_BIG + 240 * MiB, WS_KVM = WS_BIG + 288 * MiB, WS_KF = WS_BIG + 348 * MiB, WS_MIX = WS_BIG + 393 * MiB, WS_DSCR = WS_BIG + 489 * MiB;
constexpr size_t WS_GSCR = WS_BIG, WS_EDGE = WS_BIG + 16 * MiB, WS_PP = WS_BIG + 32 * MiB, WS_ACT = WS_BIG + 128 * MiB;
constexpr size_t WS_XB2 = WS_BIG + 521 * MiB;
constexpr size_t WS_W2 = WS_XB2 + 96 * MiB;
constexpr size_t WS_END = WS_W2 + (WS_XB - WS_WIN);
static_assert(WS_WQB >= WS_WIN + (size_t)NPROJ_P * DM * 2 && WS_WGU + (size_t)LD_GU * DM * 2 <= WS_WDN && WS_WDN + (size_t)DM * DFF * 2 <= WS_WPG && WS_PB + (size_t)MROWS * PLE * 2 <= WS_XB, "ws map");
static_assert(WS_PROJ + (size_t)MROWS * NPROJ_P * 2 <= WS_QM && WS_QM + (size_t)MROWS * LD_QM * 2 <= WS_KVM && WS_KVM + (size_t)MROWS * LD_KVM * 2 <= WS_KF && WS_KF + (size_t)MROWS * LD_KF * 2 <= WS_MIX && WS_MIX + (size_t)MROWS * DM * 2 <= WS_DSCR && WS_DSCR + (size_t)32 * MiB <= WS_XB2 && WS_ACT + (size_t)MROWS * DFF * 2 <= WS_MIX, "ws map 2");
static_assert(WS_EDGE + (size_t)6 * 96 * DFF * 4 <= WS_PP && WS_PP + (size_t)MROWS * DM * 2 <= WS_ACT && WS_ACT + (size_t)MROWS * DFF * 2 <= WS_XB2, "ws map 3");

constexpr int CW_BAR = 4096, CW_Q = 16384;

constexpr int NWAVES = 8;
constexpr int RING_OFF = 0, RING_BYTES = 131072;
constexpr int LDSCTL_OFF = RING_BYTES, MISC_OFF = LDSCTL_OFF + 320, BIAS_OFF = LDSCTL_OFF + 1024;
constexpr int XLDS_OFF = LDSCTL_OFF + 4096;
constexpr int LDS_BYTES = 147456;
static_assert(BIAS_OFF + 704 * 4 <= LDS_BYTES && att::ATT_LDS <= RING_BYTES, "LDS map");

#define RLX_AGENT __ATOMIC_RELAXED, __HIP_MEMORY_SCOPE_AGENT

#define XB_TMO      128
#define XB_XCNT(j)  (256  + 64 * (j))
#define XB_XSUB(j)  (1280 + 64 * (j))
#define XB_XGEN(j)  (2304 + 64 * (j))
#define XB_TOP      3328
#define XB_TOPGEN   3392
#define XCD_BAR_WORDS 3456
#define XB_SPIN_CAP (1u << 18)
__device__ __forceinline__ unsigned xb_ld(unsigned* p)              { return __hip_atomic_load(p, __ATOMIC_RELAXED, __HIP_MEMORY_SCOPE_AGENT); }
__device__ __forceinline__ unsigned xb_add(unsigned* p, unsigned v) { return __hip_atomic_fetch_add(p, v, __ATOMIC_RELAXED, __HIP_MEMORY_SCOPE_AGENT); }
__device__ __forceinline__ unsigned xb_xcc_id() { return (unsigned)__builtin_amdgcn_s_getreg((3 << 11) | 20) & 0xFu; }
#define XB_SPIN(cond, bar) do { unsigned _sp = 0; while (cond) { __builtin_amdgcn_s_sleep(1); \
    if ((++_sp & 255u) == 0u) { if (xb_ld(&(bar)[XB_TMO])) break; if (_sp > XB_SPIN_CAP) { atomicAdd(&(bar)[XB_TMO], 1u); break; } } } } while (0)
struct XcdBarrier { unsigned* bar; unsigned x; volatile LAS unsigned* st; int wave; };
__device__ __forceinline__ XcdBarrier xcd_barrier_post(unsigned* bar, volatile LAS unsigned* st) {
    XcdBarrier b; b.bar = bar; b.x = xb_xcc_id(); b.st = st; b.wave = 0;
    if (threadIdx.x == 0) (void)xb_add(&bar[XB_XCNT(b.x)], 1u);
    return b;
}
__device__ __forceinline__ void xcd_barrier_complete(unsigned* bar, unsigned x, unsigned& nloc, unsigned& nx) {
    const unsigned G = gridDim.x * gridDim.y * gridDim.z;
    unsigned sum, cnt, mine, sp = 0u;
    for (;;) {
        sum = 0u; cnt = 0u; mine = 0u;
#pragma unroll
        for (unsigned j = 0; j < 16; ++j) { const unsigned c = xb_ld(&bar[XB_XCNT(j)]); sum += c; cnt += (c > 0u) ? 1u : 0u; mine = (j == x) ? c : mine; }
        if (sum == G) break;
        __builtin_amdgcn_s_sleep(1);
        if ((++sp & 255u) == 0u) { if (xb_ld(&bar[XB_TMO])) break; if (sp > XB_SPIN_CAP) { atomicAdd(&bar[XB_TMO], 1u); break; } }
    }
    nloc = mine > 0u ? mine : 1u; nx = cnt > 0u ? cnt : 1u;
}
__device__ __forceinline__ void xcd_barrier(const XcdBarrier& b) {
    asm volatile("s_waitcnt vmcnt(0)" ::: "memory");
    __syncthreads();
    if (b.wave == 0 && lane_id() == 0) {
        unsigned* bar = b.bar;
        __builtin_amdgcn_s_waitcnt(0);
        unsigned nloc = b.st[0], nx = b.st[1];
        if (nloc == 0u) { xcd_barrier_complete(bar, b.x, nloc, nx); b.st[0] = nloc; b.st[1] = nx; }
        const unsigned old = xb_add(&bar[XB_XSUB(b.x)], 1u);
        const unsigned gen = old / nloc;
        if (old + 1u == (gen + 1u) * nloc) {
            __builtin_amdgcn_fence(__ATOMIC_RELEASE, "agent");
            asm volatile("s_waitcnt vmcnt(0)" ::: "memory");
            const unsigned og = xb_add(&bar[XB_TOP], 1u);
            const unsigned tg = og / nx;
            if (og + 1u == (tg + 1u) * nx) xb_add(&bar[XB_TOPGEN], 1u);
            else XB_SPIN(xb_ld(&bar[XB_TOPGEN]) == tg, bar);
            __builtin_amdgcn_fence(__ATOMIC_ACQUIRE, "agent");
            xb_add(&bar[XB_XGEN(b.x)], 1u);
            asm volatile("s_waitcnt vmcnt(0)" ::: "memory");
        } else {
            XB_SPIN(xb_ld(&bar[XB_XGEN(b.x)]) == gen, bar);
            __builtin_amdgcn_fence(__ATOMIC_ACQUIRE, "agent");
            asm volatile("s_waitcnt vmcnt(0)" ::: "memory");
        }
    }
    __syncthreads();
}

struct Args {
    const float* in[34]; float* out; unsigned char* ws;
    float inv_m[32]; float inv_d[8]; float lam_init[4];
    int ph_lo, ph_hi;
};

struct Frame {
    LAS unsigned char* lds; volatile LAS unsigned* MISC; unsigned* ctl;
    int wave, vcu, G;
};

__device__ __forceinline__ int seq_pos(int row) { return row < SEQ_P ? row : ((row - SEQ_P) & (SEQ_S - 1)); }

__device__ __forceinline__ void transpose_item(const float* W, const float* gain, int K, int N, bf16_t* WT, int row_off, LAS float* scr, int item, int lane, int ilv = 0) {
    const int nblk = N / 32, kb = item / nblk, nb = item % nblk, k0 = 64 * kb, n0 = 32 * nb;
    if (ilv) row_off = (n0 >> 7) * 256 + (n0 & 127) - n0 + (ilv == 2 ? 128 : 0);
    float wv[32];
    { const float* wp = W + (size_t)(k0 + (lane >> 5)) * N + n0 + (lane & 31);
#pragma unroll
      for (int i = 0; i < 32; ++i) wv[i] = wp[(size_t)(2 * i) * N]; }
    { const float g0 = gain ? gain[k0 + (lane & 31) * 2] : 1.f, g1 = gain ? gain[k0 + (lane & 31) * 2 + 1] : 1.f;
#pragma unroll
      for (int i = 0; i < 32; ++i) { const float ga = __int_as_float(__builtin_amdgcn_readlane(__float_as_int(g0), i)), gb = __int_as_float(__builtin_amdgcn_readlane(__float_as_int(g1), i));
          scr[(2 * i + (lane >> 5)) * 33 + (lane & 31)] = wv[i] * ((lane >> 5) ? gb : ga); } }
    asm volatile("s_waitcnt lgkmcnt(0)" ::: "memory");
    const int c = lane & 7;
#pragma unroll
    for (int j = 0; j < 4; ++j) { const int n = (lane >> 3) + 8 * j; const LAS float* s = scr + (8 * c) * 33 + n;
        u32x4 o; o.x = cvt_pk_bf16(s[0 * 33], s[1 * 33]); o.y = cvt_pk_bf16(s[2 * 33], s[3 * 33]); o.z = cvt_pk_bf16(s[4 * 33], s[5 * 33]); o.w = cvt_pk_bf16(s[6 * 33], s[7 * 33]);
        *(u32x4*)(WT + (size_t)(row_off + n0 + n) * K + k0 + 8 * c) = o; }
    asm volatile("s_waitcnt lgkmcnt(0)" ::: "memory");
}

__device__ __forceinline__ void sincos_acc(float ang, float& s, float& c) {
    const double a = (double)ang;
    const double k = rint(a * 0.15915494309189535);
    double rd = fma(-k, 6.283185307179586, a); rd = fma(-k, 2.4492935982947064e-16, rd);
    const float r = (float)rd, r2 = r * r;
    float sp = -1.9572941063391263e-20f;
    sp = fmaf(sp, r2, 8.220635246624329e-18f); sp = fmaf(sp, r2, -2.8114572543455206e-15f); sp = fmaf(sp, r2, 7.647163731819816e-13f); sp = fmaf(sp, r2, -1.6059043836821613e-10f);
    sp = fmaf(sp, r2, 2.505210838544172e-08f); sp = fmaf(sp, r2, -2.7557319223985893e-06f); sp = fmaf(sp, r2, 1.984126984126984e-04f); sp = fmaf(sp, r2, -8.333333333333333e-03f);
    sp = fmaf(sp, r2, 1.6666666666666666e-01f); sp = fmaf(sp, -r2, 1.0f);
    float cp = 8.896791392450574e-22f;
    cp = fmaf(cp, r2, -4.110317623312165e-19f); cp = fmaf(cp, r2, 1.5619206968586225e-16f); cp = fmaf(cp, r2, -4.779477332387385e-14f); cp = fmaf(cp, r2, 1.1470745597729725e-11f);
    cp = fmaf(cp, r2, -2.08767569878681e-09f); cp = fmaf(cp, r2, 2.755731922398589e-07f); cp = fmaf(cp, r2, -2.48015873015873e-05f); cp = fmaf(cp, r2, 1.388888888888889e-03f);
    cp = fmaf(cp, r2, -4.1666666666666664e-02f); cp = fmaf(cp, r2, 0.5f); cp = fmaf(cp, -r2, 1.0f);
    s = sp * r; c = cp;
}

__device__ __forceinline__ float norm64_rope(float v, float gain, int lane, int npair, float c, float s) {
    const float ss = wsum64(v * v);
    v = v * rsqrtf(ss * (1.0f / 64.0f) + EPS) * gain;
    float p;
    if (npair == 32) { auto rr = __builtin_amdgcn_permlane32_swap(__float_as_uint(v), __float_as_uint(v), false, false); p = __uint_as_float(lane < 32 ? rr[1] : rr[0]); }
    else p = swz_xor<8>(v);
    if (lane < 2 * npair) v = (lane < npair) ? (v * c - p * s) : (p * s + v * c);
    return v;
}


constexpr int I_IN = (DM / 64) * (NPROJ / 32), I_QB = (512 / 64) * (960 / 32), I_KVB = (256 / 64) * (1280 / 32), I_OUT = (DM / 64) * (DM / 32), I_G = (DM / 64) * (DFF / 32), I_DN = (DFF / 64) * (DM / 32), I_PP = (PLE / 64) * (DM / 32);
constexpr int NITEMS = I_IN + I_QB + I_KVB + I_OUT + 2 * I_G + I_DN + I_OUT + I_PP;
constexpr int IT_A = I_IN + I_QB + I_KVB + I_OUT, IT_B = IT_A + 2 * I_G;
struct CvtSrc { const float *w_in, *g_mix, *w_qb, *g_cq, *w_kvb, *g_ckv, *w_out, *w_gate, *w_up, *g_ffn, *w_down, *w_pg, *g_ple, *w_pp, *p_p, *p_s; };
__device__ __forceinline__ CvtSrc cvt_src(const Args& a, int LW) {
    CvtSrc c; c.w_in = a.in[5] + (size_t)LW * DM * NPROJ; c.g_mix = a.in[4] + LW * DM; c.w_qb = a.in[10] + (size_t)LW * 512 * 960; c.g_cq = a.in[9] + LW * 512; c.w_kvb = a.in[12] + (size_t)LW * 256 * 1280; c.g_ckv = a.in[11] + LW * 256;
    c.w_out = a.in[24] + (size_t)LW * DM * DM; c.w_gate = a.in[26] + (size_t)LW * DM * DFF; c.w_up = a.in[27] + (size_t)LW * DM * DFF; c.g_ffn = a.in[25] + LW * DM;
    c.w_down = a.in[30] + (size_t)LW * DFF * DM; c.w_pg = a.in[32] + (size_t)LW * DM * DM; c.g_ple = a.in[31] + LW * DM; c.w_pp = a.in[33] + (size_t)LW * PLE * DM;
    c.p_p = a.in[2] + (size_t)LW * SEQ_P * PLE; c.p_s = a.in[3] + (size_t)LW * 2 * SEQ_S * PLE; return c;
}
__device__ __forceinline__ void cvt_item(const CvtSrc c, int it, unsigned char* wbase, LAS float* scr, int lane) {
    int r = it;
    if (r < I_IN) { transpose_item(c.w_in, c.g_mix, DM, NPROJ, (bf16_t*)(wbase + WS_WIN), 0, scr, r, lane); return; } r -= I_IN;
    if (r < I_QB) { transpose_item(c.w_qb, c.g_cq, 512, 960, (bf16_t*)(wbase + WS_WQB), 0, scr, r, lane); return; } r -= I_QB;
    if (r < I_KVB) { transpose_item(c.w_kvb, c.g_ckv, 256, 1280, (bf16_t*)(wbase + WS_WKVB), 0, scr, r, lane); return; } r -= I_KVB;
    if (r < I_OUT) { transpose_item(c.w_out, nullptr, DM, DM, (bf16_t*)(wbase + WS_WOUT), 0, scr, r, lane); return; } r -= I_OUT;
    if (r < I_G) { transpose_item(c.w_gate, c.g_ffn, DM, DFF, (bf16_t*)(wbase + WS_WGU), 0, scr, r, lane, 1); return; } r -= I_G;
    if (r < I_G) { transpose_item(c.w_up, c.g_ffn, DM, DFF, (bf16_t*)(wbase + WS_WGU), 0, scr, r, lane, 2); return; } r -= I_G;
    if (r < I_DN) { transpose_item(c.w_down, nullptr, DFF, DM, (bf16_t*)(wbase + WS_WDN), 0, scr, r, lane); return; } r -= I_DN;
    if (r < I_OUT) { transpose_item(c.w_pg, c.g_ple, DM, DM, (bf16_t*)(wbase + WS_WPG), 0, scr, r, lane); return; } r -= I_OUT;
    transpose_item(c.w_pp, nullptr, PLE, DM, (bf16_t*)(wbase + WS_WPP), 0, scr, r, lane);
}
__device__ __forceinline__ void cvt_prow(const CvtSrc c, int m, unsigned char* wbase, int lane) {
    const float* src = (m < SEQ_P) ? c.p_p + (size_t)m * PLE : c.p_s + (size_t)(m - SEQ_P) * PLE;
    const f32x4 v = ((const f32x4*)src)[lane]; u32x2 w; w.x = cvt_pk_bf16(v[0], v[1]); w.y = cvt_pk_bf16(v[2], v[3]); ((u32x2*)((bf16_t*)(wbase + WS_PB) + (size_t)m * PLE))[lane] = w;
}

__global__ void __launch_bounds__(NWAVES * 64, 2) enc_fwd(Args args) {
    extern __shared__ __attribute__((aligned(16))) unsigned char lds[];
    Frame F;
    F.lds = (LAS unsigned char*)lds;
    F.MISC = (volatile LAS unsigned*)(F.lds + MISC_OFF);
    F.wave = __builtin_amdgcn_readfirstlane((int)threadIdx.x >> 6);
    F.G = gridDim.x; { const int bx = blockIdx.x; F.vcu = (F.G % 8 == 0) ? (bx % 8) * (F.G / 8) + bx / 8 : bx; }
    unsigned char* ws = args.ws;
    F.ctl = (unsigned*)(ws + WS_CTL);
    for (int u = threadIdx.x; u < (LDS_BYTES - LDSCTL_OFF) / 4; u += NWAVES * 64) ((LAS unsigned*)(F.lds + LDSCTL_OFF))[u] = 0u;
    __syncthreads();
#if MK_SPLIT
    XcdBarrier bar; bar.bar = nullptr; bar.x = 0; bar.st = nullptr; bar.wave = 0;
#define GRID_BAR() do { } while (0)
#else
    XcdBarrier bar = xcd_barrier_post(F.ctl + CW_BAR, F.MISC + 8); bar.wave = F.wave;
#define GRID_BAR() xcd_barrier(bar)
#endif
    const int lo = args.ph_lo, hi = args.ph_hi;
#define IN(k) (lo <= (k) && (k) < hi)
#define SEAM(k) do { if (IN((k) + 1)) GRID_BAR(); } while (0)

#define COSM ((float*)(wsl + WS_COSM))
#define SINM ((float*)(wsl + WS_SINM))
#define COSD ((float*)(wsl + WS_COSD))
#define SIND ((float*)(wsl + WS_SIND))
#define SSA ((float*)(wsl + WS_SSA))
#define SSB ((float*)(wsl + WS_SSB))
#define SSQ ((float*)(wsl + WS_SSQ))
#define WIN_L(LW) ((bf16_t*)(wsl + WS_WIN + (((LW) & 1) ? (WS_W2 - WS_WIN) : 0)))
#define WIN WIN_L(L)
#define WQB_L(LW) ((bf16_t*)(wsl + WS_WQB + (((LW) & 1) ? (WS_W2 - WS_WIN) : 0)))
#define WQB WQB_L(L)
#define WKVB_L(LW) ((bf16_t*)(wsl + WS_WKVB + (((LW) & 1) ? (WS_W2 - WS_WIN) : 0)))
#define WKVB WKVB_L(L)
#define WOUT_L(LW) ((bf16_t*)(wsl + WS_WOUT + (((LW) & 1) ? (WS_W2 - WS_WIN) : 0)))
#define WOUT WOUT_L(L)
#define WGU_L(LW) ((bf16_t*)(wsl + WS_WGU + (((LW) & 1) ? (WS_W2 - WS_WIN) : 0)))
#define WGU WGU_L(L)
#define WDN_L(LW) ((bf16_t*)(wsl + WS_WDN + (((LW) & 1) ? (WS_W2 - WS_WIN) : 0)))
#define WDN WDN_L(L)
#define WPG_L(LW) ((bf16_t*)(wsl + WS_WPG + (((LW) & 1) ? (WS_W2 - WS_WIN) : 0)))
#define WPG WPG_L(L)
#define WPP_L(LW) ((bf16_t*)(wsl + WS_WPP + (((LW) & 1) ? (WS_W2 - WS_WIN) : 0)))
#define WPP WPP_L(L)
#define PB_L(LW) ((bf16_t*)(wsl + WS_PB + (((LW) & 1) ? (WS_W2 - WS_WIN) : 0)))
#define PB PB_L(L)
#define XB ((bf16_t*)(wsl + ((L & 1) ? WS_XB2 : WS_XB)))
#define XBN ((bf16_t*)(wsl + ((L & 1) ? WS_XB : WS_XB2)))
#define PROJ ((bf16_t*)(wsl + WS_PROJ))
#define QM ((bf16_t*)(wsl + WS_QM))
#define KVM ((bf16_t*)(wsl + WS_KVM))
#define KF ((bf16_t*)(wsl + WS_KF))
#define MIX ((bf16_t*)(wsl + WS_MIX))
#define DSCR ((float*)(wsl + WS_DSCR))
#define EDGE ((float*)(wsl + WS_EDGE))
#define ACT ((bf16_t*)(wsl + WS_ACT))
#define PP ((bf16_t*)(wsl + WS_PP))
#define PHASE_BEGIN() size_t wso_ = 0; asm volatile("" : "+s"(wso_)); unsigned char* wsl = ws + wso_; int lane = lane_id(); asm volatile("" : "+v"(lane)); const int ptid = F.wave * 64 + lane; (void)lane; (void)ptid; (void)wsl
#define XOUT (args.out)
#define gw (F.vcu * NWAVES + F.wave)
#define NGW (F.G * NWAVES)
#define NGT (F.G * NWAVES * 64)


#define NEXT_UNIT(ctr, uvar) do { if (F.wave == 0 && lane_id() == 0) F.MISC[12] = __hip_atomic_fetch_add((ctr), 1u, RLX_AGENT); __syncthreads(); uvar = __builtin_amdgcn_readfirstlane((int)F.MISC[12]); __syncthreads(); } while (0)
#define CVT_QUEUE(ctr, first, n_items, with_prows, LW) do { \
        constexpr int nch_t_ = ((n_items) + 63) / 64, nch_ = nch_t_ + ((with_prows) ? MROWS / 512 : 0); \
        LAS float* scr_ = (LAS float*)(F.lds + RING_OFF + F.wave * 16384); \
        const CvtSrc cs_ = cvt_src(args, (LW)); unsigned char* wb_ = wsl + ((((LW)) & 1) ? (WS_W2 - WS_WIN) : 0); \
        for (;;) { int c_; NEXT_UNIT((ctr), c_); if (c_ >= nch_) break; \
            const int lane_ = lane_id(); \
            if (c_ < nch_t_) { for (int k_ = 0; k_ < 8; ++k_) { const int it_ = c_ * 64 + F.wave * 8 + k_; if (it_ < (n_items)) cvt_item(cs_, (first) + it_, wb_, scr_, lane_); } } \
            else { for (int k_ = 0; k_ < 64; ++k_) cvt_prow(cs_, (c_ - nch_t_) * 512 + F.wave * 64 + k_, wb_, lane_); } } } while (0)
#define CVT_CTR(L_, k_) (F.ctl + CW_Q + 64 * (48 + 2 * (L_) + (k_)))
    for (int L = 0; L < NLAYER; ++L) {
        const int pb = 11 * L;
        if (PH_ON(0) && IN(pb + 0) && (L == 0 || !CVT_AHEAD)) {
            PHASE_BEGIN();
            for (int rep = 0; rep < NREP(0); ++rep) { if (rep) GRID_BAR();

            LAS float* scr = (LAS float*)(F.lds + RING_OFF + F.wave * 16384);
            { const CvtSrc cs = cvt_src(args, L); unsigned char* wb = wsl + ((L & 1) ? (WS_W2 - WS_WIN) : 0);
              for (int it = gw; it < (CVT_AHEAD ? IT_A : NITEMS); it += NGW) cvt_item(cs, it, wb, scr, lane);
              if (!CVT_AHEAD) for (int m = gw; m < MROWS; m += NGW) cvt_prow(cs, m, wb, lane); }
            if (L == 0) {
                for (int i = F.vcu * (NWAVES * 64) + ptid; i < SEQ_P * 32; i += NGT) { const int t = i >> 5, k = i & 31; float s, c; sincos_acc((float)t * args.inv_m[k], s, c); COSM[i] = c; SINM[i] = s; }
                for (int i = F.vcu * (NWAVES * 64) + ptid; i < SEQ_P * 8; i += NGT) { const int t = i >> 3, k = i & 7; float s, c; sincos_acc((float)t * args.inv_d[k], s, c); COSD[i] = c; SIND[i] = s; }
                for (int m = gw; m < MROWS; m += NGW) { const float* src = (m < SEQ_P) ? args.in[0] + (size_t)m * DM : args.in[1] + (size_t)(m - SEQ_P) * DM;
                    float ss = 0.f;
#pragma unroll
                    for (int j = 0; j < 8; ++j) { const f32x4 v = ((const f32x4*)src)[j * 64 + lane]; ss += (v[0] * v[0] + v[1] * v[1]) + (v[2] * v[2] + v[3] * v[3]);
                        u32x2 w; w.x = cvt_pk_bf16(v[0], v[1]); w.y = cvt_pk_bf16(v[2], v[3]); ((u32x2*)(XB + (size_t)m * DM))[j * 64 + lane] = w; }
                    ss = wsum64(ss);
                    if (lane < 32) SSA[(size_t)m * 32 + lane] = (lane == 0) ? ss : 0.f; }
            }
            }
            SEAM(pb + 0);
        }
        if (PH_ON(1) && IN(pb + 1)) {
            PHASE_BEGIN();
            for (int rep = 0; rep < NREP(1); ++rep) { if (rep) GRID_BAR();

            pg8::Gemm g{XB, WIN, MROWS, NPROJ_P, DM, DM}; pg8::StaticOrder S; S.init(MROWS, NPROJ_P, F.G, (int)blockIdx.x);
            pg8::EpiScaleBf16<true> E{PROJ, NPROJ_P, SSA, SSQ};
            pg8::gemm_phase(F.lds + RING_OFF, g, S, E, F.wave);
            }
            if (CVT_AHEAD && NREP(1) == 1) { PHASE_BEGIN(); CVT_QUEUE(CVT_CTR(L, 0), IT_A, IT_B - IT_A, false, L); }
            SEAM(pb + 1);
        }
        if (PH_ON(2) && IN(pb + 2)) {
            PHASE_BEGIN();
            { const float* g_nak = args.in[7] + L * 128; const float* g_kpe = args.in[16] + L * 64; const float* g_dk = args.in[18] + L * 64;
            for (int m2 = gw * 4; m2 < MROWS; m2 += NGW * 4) {
                unsigned wna[4][6]; bf16_t wdf[4][10], wkpe[4]; float cm[4], sm[4], cd[4], sd[4];
#pragma unroll
                for (int rr = 0; rr < 4; ++rr) { const int m = m2 + rr; const bf16_t* pr = PROJ + (size_t)m * NPROJ_P; const int t = seq_pos(m);
#pragma unroll
                    for (int s = 0; s < 6; ++s) wna[rr][s] = ((const unsigned*)(pr + C_NAK + s * 128))[lane];
                    wkpe[rr] = pr[C_KPE + lane];
#pragma unroll
                    for (int s = 0; s < 10; ++s) wdf[rr][s] = pr[C_DFK + s * 64 + lane];
                    cm[rr] = COSM[t * 32 + (lane & 31)]; sm[rr] = SINM[t * 32 + (lane & 31)]; cd[rr] = COSD[t * 8 + (lane & 7)]; sd[rr] = SIND[t * 8 + (lane & 7)]; }
                const f32x2 gk = ((const f32x2*)g_nak)[lane]; const float gkp = g_kpe[lane], gdk = g_dk[lane];
                asm volatile("" ::: "memory");
#pragma unroll
                for (int rr = 0; rr < 4; ++rr) {
#pragma unroll
                    for (int s = 0; s < 6; ++s) { const float a = bf_lo(wna[rr][s]), b = bf_hi(wna[rr][s]);
                        const float r = rsqrtf(wsum64(a * a + b * b) * (1.0f / 128.0f) + EPS);
                        wna[rr][s] = cvt_pk_bf16(a * r * gk[0], b * r * gk[1]); }
                    wkpe[rr] = f2bf(norm64_rope(bf2f(wkpe[rr]), gkp, lane, 32, cm[rr], sm[rr]));
#pragma unroll
                    for (int s = 0; s < 10; ++s) wdf[rr][s] = f2bf(norm64_rope(bf2f(wdf[rr][s]), gdk, lane, 8, cd[rr], sd[rr])); }
                asm volatile("" ::: "memory");
#pragma unroll
                for (int rr = 0; rr < 4; ++rr) { const int m = m2 + rr; bf16_t* pr = PROJ + (size_t)m * NPROJ_P; bf16_t* kf = KF + (size_t)m * LD_KF;
#pragma unroll
                    for (int s = 0; s < 6; ++s) ((unsigned*)(pr + C_NAK + s * 128))[lane] = wna[rr][s];
#pragma unroll
                    for (int h = 0; h < 5; ++h) kf[h * 192 + 128 + lane] = wkpe[rr];
#pragma unroll
                    for (int s = 0; s < 10; ++s) pr[C_DFK + s * 64 + lane] = wdf[rr][s]; }
            } }
            asm volatile("s_waitcnt vmcnt(0) lgkmcnt(0)" ::: "memory"); __syncthreads();
            int kq = 512, kkv = 256; asm volatile("" : "+s"(kq), "+s"(kkv));
            { PHASE_BEGIN(); pg8::Gemm g{PROJ + C_CQ, WQB, MROWS, 1024, kq, NPROJ_P}; pg8::StaticOrder S; S.init(MROWS, 1024, F.G, (int)blockIdx.x);
              pg8::EpiScaleLat<8, 512> E{QM, LD_QM, SSQ}; pg8::gemm_phase(F.lds + RING_OFF, g, S, E, F.wave); }
            { PHASE_BEGIN(); pg8::Gemm g{PROJ + C_CKV, WKVB, MROWS, 1280, kkv, NPROJ_P}; pg8::StaticOrder S; S.init(MROWS, 1280, F.G, (int)blockIdx.x);
              pg8::EpiKvm E{KVM, KF, SSQ + 8, args.in[15] + L * 128, (LAS float*)(F.lds + XLDS_OFF)}; pg8::gemm_phase(F.lds + RING_OFF, g, S, E, F.wave); }
            SEAM(pb + 4);
        }
        if (PH_ON(5) && IN(pb + 5)) {
            PHASE_BEGIN();
            for (int rep = 0; rep < NREP(5); ++rep) { if (rep) GRID_BAR();

            char* alds = (char*)lds + RING_OFF;
            unsigned* qctr = F.ctl + CW_Q + 64 * (L * 6) + rep * 64 * 24;
#pragma unroll 1
            for (int pass = 0; pass < 2; ++pass) {
            const int ubase = pass ? 320 : 0, ucnt = pass ? 160 : 320;
            if (PH_ON(11)) {
                float lam;
                { const int lane = lane_id(); const float a = wsum64((args.in[19] + L * 64)[lane] * (args.in[20] + L * 64)[lane]); const float b = wsum64((args.in[21] + L * 64)[lane] * (args.in[22] + L * 64)[lane]);
                  lam = expf(a) - expf(b) + args.lam_init[L]; }
                float* scr = DSCR + (size_t)blockIdx.x * (64 * 512);
                for (;;) {
                    int u; NEXT_UNIT(qctr + 64 * (2 * pass), u); if (u >= ucnt) break; u += ubase;
                    int h, row0, kbase, nkeys;
                    if (u < 320) { h = u / 64; row0 = (u % 64) * 256; kbase = 0; nkeys = SEQ_P; }
                    else { const int v = u - 320; h = v / 32; const int w = v % 32; kbase = SEQ_P + (w / 16) * SEQ_S; row0 = kbase + (w % 16) * 256; nkeys = SEQ_S; }
                    att::AttnOut o0{nullptr, scr, 0.f, nullptr, 0.f};
                    const att::QNormDiff qn{args.in[17] + L * 64, COSD, SIND, 0.18033688011112042f  };
                    att::attn_pp<4, 1, NPROJ_P, NPROJ_P, NPROJ_P, DM, att::NoHook>(PROJ + (size_t)row0 * NPROJ_P + C_DFQ + h * 128, PROJ + (size_t)kbase * NPROJ_P + C_DFK + h * 128,
                                                         PROJ + (size_t)kbase * NPROJ_P + C_DFV + h * 128, nkeys / 64, alds, att::NoHook{}, o0, F.wave, qn, row0 - kbase);
                    att::AttnOut o1{MIX + (size_t)row0 * DM + 1408 + h * 128, scr, lam, args.in[23] + L * 128, 1.0f - args.lam_init[L]};
                    att::attn_pp<4, 2, NPROJ_P, NPROJ_P, NPROJ_P, DM, att::NoHook>(PROJ + (size_t)row0 * NPROJ_P + C_DFQ + h * 128 + 64, PROJ + (size_t)kbase * NPROJ_P + C_DFK + h * 128 + 64,
                                                         PROJ + (size_t)kbase * NPROJ_P + C_DFV + h * 128, nkeys / 64, alds, att::NoHook{}, o1, F.wave, qn, row0 - kbase);
                }
            }
            if (PH_ON(12)) for (;;) {
                int u; NEXT_UNIT(qctr + 64 * (2 * pass + 1), u); if (u >= ucnt) break; u += ubase;
                int h, row0, kbase, nkeys;
                if (u < 320) { h = u / 64; row0 = (u % 64) * 256; kbase = 0; nkeys = SEQ_P; }
                else { const int v = u - 320; h = v / 32; const int w = v % 32; kbase = SEQ_P + (w / 16) * SEQ_S; row0 = kbase + (w % 16) * 256; nkeys = SEQ_S; }
                att::AttnOut o0{MIX + (size_t)row0 * DM + 768 + h * 128, nullptr, 0.f, nullptr, 0.f};
                att::attn_pp<12, 0, LD_QM, LD_KF, LD_KVM, DM, att::NoHook>(QM + (size_t)row0 * LD_QM + h * 192, KF + (size_t)kbase * LD_KF + h * 192,
                                                      KVM + (size_t)kbase * LD_KVM + h * 256 + 128, nkeys / 64, alds, att::NoHook{}, o0, F.wave,
                                                      att::QNormMLA{args.in[13] + L * 128, args.in[14] + L * 64, COSM, SINM, 0.10411754627697264f  }, row0 - kbase);
            }
            }
            if (PH_ON(13)) for (;;) {
                int u; NEXT_UNIT(qctr + 64 * 4, u); if (u >= 576) break;
                int h, sbase, rows, r0;
                if (u < 384) { h = u / 64; sbase = 0; rows = 256; r0 = (u % 64) * 4; }
                else { const int v = u - 384; h = v / 32; const int w = v % 32; sbase = SEQ_P + (w / 16) * SEQ_S; rows = 64; r0 = (w % 16) * 4; }
                LAS float* btab = (LAS float*)(F.lds + BIAS_OFF);
                const int lane = lane_id();
                { const int ptid = F.wave * 64 + lane; const float* rpb = args.in[8] + (size_t)(L * 6 + h) * 465; if (ptid < 465) btab[48 + ptid] = rpb[ptid]; }
                int kr_lo = r0 - 4; kr_lo = kr_lo < 0 ? 0 : (kr_lo > rows - 11 ? rows - 11 : kr_lo);
                att::NaHook hook; hook.bias = (const LAS float*)(F.lds + BIAS_OFF) + 48; hook.kr_lo = kr_lo; hook.rq = r0 + (F.wave >> 1);
                { int rs = hook.rq - 4; rs = rs < 0 ? 0 : (rs > rows - 8 ? rows - 8 : rs); hook.rs = rs; }
                hook.c = 32 * (F.wave & 1) + (lane & 31); { int cs = hook.c - 8; cs = cs < 0 ? 0 : (cs > 48 ? 48 : cs); hook.cs = cs; }
                const size_t row0 = (size_t)sbase + (size_t)r0 * 64, krow0 = (size_t)sbase + (size_t)kr_lo * 64;
                att::AttnOut o0{MIX + row0 * DM + h * 128, nullptr, 0.f, nullptr, 0.f};
                att::attn_pp<8, 0, NPROJ_P, NPROJ_P, NPROJ_P, DM, att::NaHook>(PROJ + row0 * NPROJ_P + C_NAQ + h * 128, PROJ + krow0 * NPROJ_P + C_NAK + h * 128,
                                                     PROJ + krow0 * NPROJ_P + C_NAV + h * 128, 11, alds, hook, o0, F.wave, att::QNormNA{args.in[6] + L * 128, 0.12751743082459868f  }, 0);
            }
            if (CVT_AHEAD && L + 1 < NLAYER && NREP(5) == 1) CVT_QUEUE(qctr + 64 * 5, 0, IT_A, false, L + 1);
            }
            SEAM(pb + 5);
        }
        if (PH_ON(6) && IN(pb + 6)) {
            PHASE_BEGIN();
            pg8::Gemm g{MIX, WOUT, MROWS, DM, DM, DM}; pg8::StaticOrder S; S.init(MROWS, DM, F.G, (int)blockIdx.x);
            pg8::EpiResidual<false> E; E.xin = XB; E.xout = nullptr; E.xbf = XB; E.ss_out = SSA; E.ss_in = nullptr; E.pp = nullptr;
            pg8::gemm_phase(F.lds + RING_OFF, g, S, E, F.wave);
            SEAM(pb + 6);
        }
        if (PH_ON(7) && IN(pb + 7)) {
            PHASE_BEGIN();
            for (int rep = 0; rep < NREP(7); ++rep) { if (rep) GRID_BAR();

            pg8::Gemm g{XB, WGU, MROWS, LD_GU, DM, DM}; pg8::StaticOrder S; S.init(MROWS, LD_GU, F.G, (int)blockIdx.x);
            pg8::EpiGateUp E{ACT, SSA, args.in[28] + (size_t)L * 3 * DFF, args.in[29] + (size_t)L * DFF, (LAS unsigned*)(F.lds + XLDS_OFF), EDGE};
            pg8::gemm_phase(F.lds + RING_OFF, g, S, E, F.wave);
            }
            if (CVT_AHEAD && NREP(7) == 1) { PHASE_BEGIN(); CVT_QUEUE(CVT_CTR(L, 1), IT_B, NITEMS - IT_B, true, L); }
            SEAM(pb + 7);
        }
        if (PH_ON(8) && IN(pb + 8)) {
            PHASE_BEGIN();
            for (int rep = 0; rep < NREP(8); ++rep) { if (rep) GRID_BAR();

            const float* cw = args.in[28] + (size_t)L * 3 * DFF;
            const float* PF = EDGE; const float* GF = EDGE + 96 * DFF; const float* UF = EDGE + 2 * 96 * DFF; const float* PL = EDGE + 3 * 96 * DFF; const float* GL = EDGE + 4 * 96 * DFF; const float* UL = EDGE + 5 * 96 * DFF;
            for (int i = F.vcu * (NWAVES * 64) + ptid; i < 2 * 96 * (DFF / 4); i += NGT) {
                const int which = i / (96 * (DFF / 4)), j = i % (96 * (DFF / 4)), pm = j / (DFF / 4), c4 = (j % (DFF / 4)) * 4;
                const int row = pm * 256 + (which ? 255 : 0); const int t = seq_pos(row), slen = row < SEQ_P ? SEQ_P : SEQ_S;
                f32x4 pre = *(const f32x4*)((which ? PL : PF) + (size_t)pm * DFF + c4); const f32x4 uu = *(const f32x4*)((which ? UL : UF) + (size_t)pm * DFF + c4);
                if (which == 0 && t > 0) pre += *(const f32x4*)(cw + c4) * *(const f32x4*)(GL + (size_t)(pm - 1) * DFF + c4);
                if (which == 1 && t < slen - 1) pre += *(const f32x4*)(cw + 2 * DFF + c4) * *(const f32x4*)(GF + (size_t)(pm + 1) * DFF + c4);
                float o[4];
#pragma unroll
                for (int e = 0; e < 4; ++e) o[e] = pre[e] * sigm(pre[e]) * uu[e];
                u32x2 w; w.x = cvt_pk_bf16(o[0], o[1]); w.y = cvt_pk_bf16(o[2], o[3]);
                *(u32x2*)(ACT + (size_t)row * DFF + c4) = w;
            }
            }
            SEAM(pb + 8);
        }
        if (PH_ON(9) && IN(pb + 9)) {
            PHASE_BEGIN();
            { pg8::Gemm g{ACT, WDN, MROWS, DM, DFF, DFF}; pg8::StaticOrder S; S.init(MROWS, DM, F.G, (int)blockIdx.x);
              pg8::EpiResidual<false> E; E.xin = XB; E.xout = nullptr; E.xbf = XB; E.ss_out = SSB; E.ss_in = nullptr; E.pp = nullptr;
              pg8::gemm_phase(F.lds + RING_OFF, g, S, E, F.wave); }
            { PHASE_BEGIN(); int kp = PLE; asm volatile("" : "+s"(kp)); pg8::Gemm g{PB, WPP, MROWS, DM, kp, PLE};   pg8::StaticOrder S; S.init(MROWS, DM, F.G, (int)blockIdx.x);
              pg8::EpiScaleBf16<false> E{PP, DM, nullptr}; pg8::gemm_phase(F.lds + RING_OFF, g, S, E, F.wave); }
            SEAM(pb + 9);
        }
        if (PH_ON(10) && IN(pb + 10)) {
            PHASE_BEGIN();
            pg8::Gemm g{XB, WPG, MROWS, DM, DM, DM}; pg8::StaticOrder S; S.init(MROWS, DM, F.G, (int)blockIdx.x);
            pg8::EpiResidual<true> E; E.xin = XB; E.xout = (L == NLAYER - 1) ? XOUT : nullptr; E.xbf = XBN; E.ss_out = SSA; E.ss_in = SSB; E.pp = PP;
            pg8::gemm_phase(F.lds + RING_OFF, g, S, E, F.wave);
            SEAM(pb + 10);
        }
    }
#undef IN
#undef SEAM
#undef GRID_BAR
}

extern "C" void kernel_launch(void* const* d_in, const int* in_sizes, int n_in, void* d_out, int out_size, void* d_ws, size_t ws_size, hipStream_t stream) {
    static int grid = 0;
    if (grid == 0) {
        if (n_in != 34 || out_size != MROWS * DM || ws_size < WS_END) { fprintf(stderr, "kernel_launch: unexpected shapes: n_in %d out %d ws %zu (need %zu)\n", n_in, out_size, ws_size, (size_t)WS_END); grid = -1; return; }
        int dev = 0, cus = 0, per_cu = 0;
        if (hipGetDevice(&dev) != hipSuccess || hipDeviceGetAttribute(&cus, hipDeviceAttributeMultiprocessorCount, dev) != hipSuccess) { grid = -1; return; }
        if (hipFuncSetAttribute((const void*)enc_fwd, hipFuncAttributeMaxDynamicSharedMemorySize, LDS_BYTES) != hipSuccess) { fprintf(stderr, "kernel_launch: hipFuncSetAttribute failed\n"); grid = -1; return; }
        if (hipOccupancyMaxActiveBlocksPerMultiprocessor(&per_cu, (const void*)enc_fwd, NWAVES * 64, LDS_BYTES) != hipSuccess || per_cu < 1)
            fprintf(stderr, "kernel_launch: occupancy query reports %d workgroups per CU\n", per_cu);
        (void)hipGetLastError();
        grid = cus;
    }
    if (grid < 0) return;
    if (hipMemsetAsync((char*)d_ws + WS_CTL, 0, CTL_ZERO_BYTES, stream) != hipSuccess) { fprintf(stderr, "kernel_launch: memset failed\n"); return; }
    Args a{};
    for (int i = 0; i < 34; ++i) a.in[i] = (const float*)d_in[i];
    a.out = (float*)d_out; a.ws = (unsigned char*)d_ws;
    for (int i = 0; i < 32; ++i) { const float e = (float)(2 * i) / 64.0f; const float p = powf(10000.0f, e); a.inv_m[i] = 1.0f / p; }
    for (int i = 0; i < 8; ++i) { const float e = (float)(2 * i) / 16.0f; const float p = powf(500000.0f, e); a.inv_d[i] = 1.0f / p; }
    for (int i = 0; i < 4; ++i) a.lam_init[i] = (float)(0.8 - 0.6 * exp(-0.3 * (double)i));
#if MK_SPLIT
    for (int p = 0; p < 44; ++p) { a.ph_lo = p; a.ph_hi = p + 1; hipLaunchKernelGGL(enc_fwd, dim3(grid), dim3(NWAVES * 64), LDS_BYTES, stream, a); }
#else
    a.ph_lo = 0; a.ph_hi = 44;
    hipLaunchKernelGGL(enc_fwd, dim3(grid), dim3(NWAVES * 64), LDS_BYTES, stream, a);
#endif
    const hipError_t le = hipPeekAtLastError();
    if (le != hipSuccess) fprintf(stderr, "kernel_launch: launch failed: %s\n", hipGetErrorName(le));
}
```

```cpp
#include <hip/hip_runtime.h>
#include <cstdio>
#include <cstdint>
#include <cmath>
#include <utility>
#include <type_traits>

#ifndef PH_MASK
#define PH_MASK 0x3fff
#endif
#define PH_ON(k) (((PH_MASK) >> (k)) & 1)
#ifndef PROBE_MASK
#define PROBE_MASK 0
#endif
#define NREP(k) ((((PROBE_MASK) >> (k)) & 1) ? 2 : 1)
#ifndef MLA_PIPE
#define MLA_PIPE true
#endif
#ifndef CVT_AHEAD
#define CVT_AHEAD 1
#endif
#ifndef MK_SPLIT
#define MK_SPLIT 0
#endif

constexpr int DM = 2048, MROWS = 24576, NLAYER = 4, SEQ_P = 16384, SEQ_S = 4096;
constexpr int NPROJ = 5056, NPROJ_P = 5120, DFF = 5632, PLE = 256;
constexpr int C_NAQ = 0, C_NAK = 768, C_NAV = 1536, C_CQ = 2304, C_CKV = 2816, C_KPE = 3072, C_DFQ = 3136, C_DFK = 3776, C_DFV = 4416;
constexpr int LD_QM = 1024, LD_KVM = 1280, LD_KF = 960, LD_GU = 2 * DFF;
constexpr float EPS = 1e-6f;

typedef unsigned short bf16_t;
typedef short bf16x8 __attribute__((ext_vector_type(8)));
typedef short s16x4 __attribute__((ext_vector_type(4)));
typedef float f32x4 __attribute__((ext_vector_type(4)));
typedef float f32x2 __attribute__((ext_vector_type(2)));
typedef float f32x16 __attribute__((ext_vector_type(16)));
typedef unsigned u32x4 __attribute__((ext_vector_type(4)));
typedef unsigned u32x2 __attribute__((ext_vector_type(2)));

#define GAS __attribute__((address_space(1)))
#define LAS __attribute__((address_space(3)))

typedef __bf16 bf16x2_t __attribute__((ext_vector_type(2)));
__device__ __forceinline__ unsigned cvt_pk_bf16(float lo, float hi) { f32x2 v = {lo, hi}; bf16x2_t b = __builtin_convertvector(v, bf16x2_t); return __builtin_bit_cast(unsigned, b); }
__device__ __forceinline__ float bf_lo(unsigned w) { return __uint_as_float(w << 16); }
__device__ __forceinline__ float bf_hi(unsigned w) { return __uint_as_float(w & 0xffff0000u); }
__device__ __forceinline__ float bf2f(bf16_t h) { return __uint_as_float((unsigned)h << 16); }
__device__ __forceinline__ bf16_t f2bf(float f) { return (bf16_t)(cvt_pk_bf16(f, 0.f) & 0xffffu); }
__device__ __forceinline__ float sigm(float x) { return __builtin_amdgcn_rcpf(1.f + __builtin_amdgcn_exp2f(x * -1.4426950408889634f)); }
template <int X> __device__ __forceinline__ float swz_xor(float v) { return __int_as_float(__builtin_amdgcn_ds_swizzle(__float_as_int(v), (X << 10) | 0x1f)); }
__device__ __forceinline__ float xor32_sum(float v) { auto rr = __builtin_amdgcn_permlane32_swap(__float_as_uint(v), __float_as_uint(v), false, false); return __uint_as_float(rr[0]) + __uint_as_float(rr[1]); }
template <int CTRL> __device__ __forceinline__ float dpp_mov(float v) { return __int_as_float(__builtin_amdgcn_update_dpp(0, __float_as_int(v), CTRL, 0xf, 0xf, true)); }
__device__ __forceinline__ float wsum32(float v) { v += dpp_mov<0xB1>(v); v += dpp_mov<0x4E>(v); v += dpp_mov<0x141>(v); v += dpp_mov<0x140>(v); v += swz_xor<16>(v); return v; }
__device__ __forceinline__ float wsum64(float v) { return xor32_sum(wsum32(v)); }
__device__ __forceinline__ int lane_id() { int l; asm volatile("v_mbcnt_lo_u32_b32 %0, -1, 0\n\tv_mbcnt_hi_u32_b32 %0, -1, %0" : "=v"(l)); return l; }
namespace pg8 {
constexpr int BM = 256, BK = 64, HALF = 128, HTB = HALF * BK * 2, STAGE_BYTES = 8 * HTB, NXCD = 8, WGM = 4;
__host__ __device__ __forceinline__ int lds_byte(int r, int c) { const int st = (r >> 4) * 2 + (c >> 5), rr = r & 15, cc = c & 31, ob = rr * 64 + cc * 2; return st * 1024 + (ob ^ (((ob >> 9) & 1) << 5)); }
__host__ __device__ __forceinline__ void stage_rc(int b, int& R, int& C) { const int st = b / 1024, sb = b % 1024, swz = sb ^ (((sb >> 9) & 1) << 5); R = (st >> 1) * 16 + swz / 64; C = (st & 1) * 32 + (swz % 64) / 2; }
__host__ __device__ __forceinline__ int perm32(int rho) { const int n = rho >> 4, i = rho & 15; return 8 * (i >> 2) + 4 * n + (i & 3); }

struct Unit { int pm, pn; };
struct Gemm { const bf16_t* A; const bf16_t* Bt; int M, N, K, lda; };

struct StaticOrder {
    int nM, nN, nwg, G, c;
    __device__ void init(int M, int N, int G_, int c_) { nM = M / BM; nN = N / BM; nwg = nM * nN; G = G_; c = c_; }
    __device__ bool next(int i, Unit& u) const {
        const long L = (long)i * G + c; if (L >= nwg) return false;
        int wgid = (int)L; { const int q = nwg / NXCD, r = nwg % NXCD, xcd = wgid % NXCD, off = wgid / NXCD; wgid = (xcd < r ? xcd * (q + 1) : r * (q + 1) + (xcd - r) * q) + off; }
        const int nig = WGM * nN, gid = wgid / nig, fm = gid * WGM, gsz = (nM - fm) < WGM ? (nM - fm) : WGM;
        u.pm = fm + ((wgid % nig) % gsz); u.pn = (wgid % nig) / gsz; return true;
    }
};

template <class Epi>
__device__ __forceinline__ void gemm_phase(LAS unsigned char* lds, const Gemm g, const StaticOrder& S, const Epi& E, int wave) {
    int lane_ = lane_id(); asm volatile("" : "+v"(lane_));
    const int wid = wave, lane = lane_, tid = wid * 64 + lane, wr = wid >> 2, wc = wid & 3, fr = lane & 15, fq = lane >> 4;
    const int K = g.K, nt = K / BK, lda = g.lda;
    unsigned voffA[2], voffB[2];
#pragma unroll
    for (int i = 0; i < 2; ++i) { int R, C; stage_rc(tid * 16 + i * 8192, R, C); const int Rb = (R & ~31) + perm32(R & 31);
        voffA[i] = (unsigned)(R * lda + C) * 2u; voffB[i] = (unsigned)(Rb * K + C) * 2u; }
    const size_t kstep = (size_t)(BK * 2);
    const size_t hstepA = (size_t)HALF * lda * 2, hstepB = (size_t)HALF * K * 2;
    const size_t tstepA = 2 * hstepA, tstepB = 2 * hstepB;
    const unsigned ldsw = (unsigned)wid * 1024u;
    const int aoff = lds_byte(wr * 64 + fr, fq * 8), boff = lds_byte(wc * 32 + fr, fq * 8);
#define PG8_SA(b, h) (((b) * 2 + (h)) * HTB)
#define PG8_SB(b, h) ((4 + (b) * 2 + (h)) * HTB)
#define PG8_STAGE(bufoff, gbase, voff) do { _Pragma("unroll") for (int _i = 0; _i < 2; ++_i) \
        __builtin_amdgcn_global_load_lds((const unsigned*)((const char*)(gbase) + (voff)[_i]), (LAS unsigned*)(lds + (bufoff) + ldsw + _i * 8192), 16, 0, 0); } while (0)
#define PG8_LDA(dst, b, h) do { _Pragma("unroll") for (int m = 0; m < 4; ++m) _Pragma("unroll") for (int k = 0; k < 2; ++k) dst[m][k] = *(const LAS bf16x8*)(lds + PG8_SA(b, h) + aoff + m * 2048 + k * 1024); } while (0)
#define PG8_LDB(dst, b, h) do { _Pragma("unroll") for (int n = 0; n < 2; ++n) _Pragma("unroll") for (int k = 0; k < 2; ++k) dst[n][k] = *(const LAS bf16x8*)(lds + PG8_SB(b, h) + boff + n * 2048 + k * 1024); } while (0)
#define PG8_MMA(ai, bj, At, Bt) do { __builtin_amdgcn_s_setprio(1); _Pragma("unroll") for (int m = 0; m < 4; ++m) _Pragma("unroll") for (int n = 0; n < 2; ++n) _Pragma("unroll") for (int k = 0; k < 2; ++k) \
        acc[ai][bj][m][n] = __builtin_amdgcn_mfma_f32_16x16x32_bf16(Bt[n][k], At[m][k], acc[ai][bj][m][n], 0, 0, 0); __builtin_amdgcn_s_setprio(0); } while (0)
#define PG8_WAIT_V(n) asm volatile("s_waitcnt vmcnt(" #n ")" ::: "memory")
#define PG8_WAIT_L(n) asm volatile("s_waitcnt lgkmcnt(" #n ")" ::: "memory")
#define PG8_BAR __builtin_amdgcn_s_barrier()
#define PG8_SCHED __builtin_amdgcn_sched_barrier(0)
    Unit cur, nxt; int ui = 0;
    if (!S.next(0, cur)) return;
    f32x4 acc[2][2][4][2];
#pragma unroll
    for (int a = 0; a < 2; ++a)
#pragma unroll
        for (int b = 0; b < 2; ++b)
#pragma unroll
            for (int m = 0; m < 4; ++m)
#pragma unroll
                for (int n = 0; n < 2; ++n) acc[a][b][m][n] = (f32x4){0.f, 0.f, 0.f, 0.f};
    bf16x8 At[4][2], B0[2][2], B1[2][2];
    const char* cA = (const char*)g.A + (size_t)cur.pm * tstepA; const char* cB = (const char*)g.Bt + (size_t)cur.pn * tstepB;
    PG8_STAGE(PG8_SB(0, 0), cB, voffB); PG8_STAGE(PG8_SB(0, 1), cB + hstepB, voffB); PG8_STAGE(PG8_SA(0, 0), cA, voffA); PG8_STAGE(PG8_SA(0, 1), cA + hstepA, voffA);
    if (wr == 1) PG8_BAR;
    PG8_WAIT_V(2); PG8_BAR;
    PG8_STAGE(PG8_SB(1, 0), cB + kstep, voffB); PG8_STAGE(PG8_SA(1, 0), cA + kstep, voffA); PG8_STAGE(PG8_SB(1, 1), cB + hstepB + kstep, voffB);
    PG8_WAIT_V(6); PG8_BAR;
    for (;;) {
        const bool has_next = S.next(ui + 1, nxt);
        const char* nA = has_next ? (const char*)g.A + (size_t)nxt.pm * tstepA : cA; const char* nB = has_next ? (const char*)g.Bt + (size_t)nxt.pn * tstepB : cB;
        for (int t = 0; t < nt; t += 2) {
            const bool last = (t == nt - 2);
            const char* a1 = cA + (size_t)(t + 1) * kstep;
            const char* a2 = last ? nA : cA + (size_t)(t + 2) * kstep; const char* b2 = last ? nB : cB + (size_t)(t + 2) * kstep;
            const char* a3 = a2 + kstep; const char* b3 = b2 + kstep;
            PG8_LDB(B0, 0, 0); PG8_LDB(B1, 0, 1); PG8_SCHED; PG8_LDA(At, 0, 0); PG8_STAGE(PG8_SA(1, 1), a1 + hstepA, voffA);
            PG8_WAIT_V(8); PG8_WAIT_L(0); PG8_BAR; PG8_MMA(0, 0, At, B0); PG8_MMA(0, 1, At, B1); PG8_BAR; PG8_SCHED;
            PG8_LDA(At, 0, 1); PG8_STAGE(PG8_SB(0, 0), b2, voffB); PG8_STAGE(PG8_SB(0, 1), b2 + hstepB, voffB); PG8_STAGE(PG8_SA(0, 0), a2, voffA);
            PG8_WAIT_V(8); PG8_WAIT_L(0); PG8_BAR; PG8_MMA(1, 0, At, B0); PG8_MMA(1, 1, At, B1); PG8_BAR; PG8_SCHED;
            PG8_LDB(B0, 1, 0); PG8_LDB(B1, 1, 1); PG8_SCHED; PG8_LDA(At, 1, 0); PG8_STAGE(PG8_SA(0, 1), a2 + hstepA, voffA);
            PG8_WAIT_V(8); PG8_WAIT_L(0); PG8_BAR; PG8_MMA(0, 0, At, B0); PG8_MMA(0, 1, At, B1); PG8_BAR; PG8_SCHED;
            PG8_LDA(At, 1, 1); PG8_STAGE(PG8_SB(1, 0), b3, voffB); PG8_STAGE(PG8_SB(1, 1), b3 + hstepB, voffB); PG8_STAGE(PG8_SA(1, 0), a3, voffA);
            PG8_WAIT_V(8); PG8_WAIT_L(0); PG8_BAR; PG8_MMA(1, 0, At, B0); PG8_MMA(1, 1, At, B1); PG8_BAR; PG8_SCHED;
        }
        if (wr == 0) PG8_BAR;
        E(acc, cur, wr, wc, fr, fq);
        if (!has_next) break;
#pragma unroll
        for (int a = 0; a < 2; ++a)
#pragma unroll
            for (int b = 0; b < 2; ++b)
#pragma unroll
                for (int m = 0; m < 4; ++m)
#pragma unroll
                    for (int n = 0; n < 2; ++n) acc[a][b][m][n] = (f32x4){0.f, 0.f, 0.f, 0.f};
        cur = nxt; cA = nA; cB = nB; ++ui;
        if (wr == 1) PG8_BAR;
    }
    PG8_WAIT_V(0);
    PG8_BAR;
#undef PG8_SA
#undef PG8_SB
#undef PG8_STAGE
#undef PG8_LDA
#undef PG8_LDB
#undef PG8_MMA
#undef PG8_WAIT_V
#undef PG8_WAIT_L
#undef PG8_BAR
#undef PG8_SCHED
}

__device__ __forceinline__ void load_rstd(const float* ss, int row_base, int fq, float (&rs)[2][4]) {
#pragma unroll
    for (int ai = 0; ai < 2; ++ai)
#pragma unroll
        for (int m = 0; m < 4; ++m) {
            const f32x4* p = (const f32x4*)(ss + (size_t)(row_base + ai * HALF + m * 16) * 32 + fq * 8);
            const f32x4 a = p[0], b = p[1];
            float s = ((a[0] + a[1]) + (a[2] + a[3])) + ((b[0] + b[1]) + (b[2] + b[3]));
            s += swz_xor<16>(s); s = xor32_sum(s);
            rs[ai][m] = rsqrtf(s * (1.0f / DM) + EPS);
        }
}
template <bool RS> struct EpiScaleBf16 {
    bf16_t* O; int ldc; const float* ss; float* ssq;
    __device__ __forceinline__ void operator()(const f32x4 (&acc)[2][2][4][2], const Unit& u, int wr, int wc, int fr, int fq) const {
        const int row0 = u.pm * BM + wr * 64 + fr, col0 = u.pn * BM + wc * 32 + 8 * fq;
        float rs[2][4];
        if (RS) load_rstd(ss, row0, fq, rs);
        const bool wsq = ssq != nullptr && u.pn >= 9 && u.pn < 12;
#pragma unroll
        for (int ai = 0; ai < 2; ++ai)
#pragma unroll
            for (int m = 0; m < 4; ++m) { bf16_t* rowp = O + (size_t)(row0 + ai * HALF + m * 16) * ldc + col0; const float sc = RS ? rs[ai][m] : 1.f;
                float sq = 0.f;
#pragma unroll
                for (int bj = 0; bj < 2; ++bj) { const f32x4 v0 = acc[ai][bj][m][0] * sc, v1 = acc[ai][bj][m][1] * sc;
                    u32x4 w; w.x = cvt_pk_bf16(v0[0], v0[1]); w.y = cvt_pk_bf16(v0[2], v0[3]); w.z = cvt_pk_bf16(v1[0], v1[1]); w.w = cvt_pk_bf16(v1[2], v1[3]);
                    *(u32x4*)(rowp + bj * HALF) = w;
                    if (wsq) sq += (v0[0] * v0[0] + v0[1] * v0[1]) + (v0[2] * v0[2] + v0[3] * v0[3]) + (v1[0] * v1[0] + v1[1] * v1[1]) + (v1[2] * v1[2] + v1[3] * v1[3]); }
                if (wsq) { sq += swz_xor<16>(sq); sq = xor32_sum(sq); if (fq == 0) ssq[(size_t)(row0 + ai * HALF + m * 16) * 16 + (u.pn - 9) * 4 + wc] = sq; } }
    }
};
template <int NP, int DIVN> struct EpiScaleLat {
    bf16_t* O; int ldc; const float* ssq;
    __device__ __forceinline__ void operator()(const f32x4 (&acc)[2][2][4][2], const Unit& u, int wr, int wc, int fr, int fq) const {
        const int l_ = lane_id(), fql = l_ >> 4;
        const int row0 = u.pm * BM + wr * 64 + (l_ & 15), col0 = u.pn * BM + wc * 32 + 8 * fql; (void)fr; (void)fq;
        float rs[2][4];
#pragma unroll
        for (int ai = 0; ai < 2; ++ai)
#pragma unroll
            for (int m = 0; m < 4; ++m) {
                const float* p = ssq + (size_t)(row0 + ai * HALF + m * 16) * 16 + fql * (NP / 4);
                float sq = p[0]; if (NP == 8) sq += p[1];
                sq += swz_xor<16>(sq); sq = xor32_sum(sq);
                rs[ai][m] = rsqrtf(sq * (1.0f / DIVN) + EPS);
            }
#pragma unroll
        for (int ai = 0; ai < 2; ++ai)
#pragma unroll
            for (int m = 0; m < 4; ++m) { bf16_t* rowp = O + (size_t)(row0 + ai * HALF + m * 16) * ldc + col0; const float sc = rs[ai][m];
#pragma unroll
                for (int bj = 0; bj < 2; ++bj) { const f32x4 v0 = acc[ai][bj][m][0] * sc, v1 = acc[ai][bj][m][1] * sc;
                    u32x4 w; w.x = cvt_pk_bf16(v0[0], v0[1]); w.y = cvt_pk_bf16(v0[2], v0[3]); w.z = cvt_pk_bf16(v1[0], v1[1]); w.w = cvt_pk_bf16(v1[2], v1[3]);
                    *(u32x4*)(rowp + bj * HALF) = w; } }
    }
};
struct EpiKvm {
    bf16_t* kvm; bf16_t* kf; const float* ssq; const float* g_kn; LAS float* xl;
    __device__ __forceinline__ void operator()(const f32x4 (&acc)[2][2][4][2], const Unit& u, int wr, int wc, int fr, int fq) const {
        const int l_ = lane_id(), fql = l_ >> 4, rowl = wr * 64 + (l_ & 15), colh = wc * 32 + 8 * fql; (void)fr; (void)fq;
        const int row0 = u.pm * BM + rowl;
        float rs[2][4];
#pragma unroll
        for (int ai = 0; ai < 2; ++ai)
#pragma unroll
            for (int m = 0; m < 4; ++m) {
                const float* p = ssq + (size_t)(row0 + ai * HALF + m * 16) * 16 + fql;
                float sq = p[0]; sq += swz_xor<16>(sq); sq = xor32_sum(sq);
                rs[ai][m] = rsqrtf(sq * (1.0f / 256.0f) + EPS);
            }
#pragma unroll
        for (int ai = 0; ai < 2; ++ai)
#pragma unroll
            for (int m = 0; m < 4; ++m) { const float sc = rs[ai][m];
                { const f32x4 v0 = acc[ai][1][m][0] * sc, v1 = acc[ai][1][m][1] * sc;
                  u32x4 w; w.x = cvt_pk_bf16(v0[0], v0[1]); w.y = cvt_pk_bf16(v0[2], v0[3]); w.z = cvt_pk_bf16(v1[0], v1[1]); w.w = cvt_pk_bf16(v1[2], v1[3]);
                  *(u32x4*)(kvm + (size_t)(row0 + ai * HALF + m * 16) * LD_KVM + u.pn * 256 + 128 + colh) = w; }
                const f32x4 k0 = acc[ai][0][m][0] * sc, k1 = acc[ai][0][m][1] * sc;
                float sq = (k0[0] * k0[0] + k0[1] * k0[1]) + (k0[2] * k0[2] + k0[3] * k0[3]) + (k1[0] * k1[0] + k1[1] * k1[1]) + (k1[2] * k1[2] + k1[3] * k1[3]);
                sq += swz_xor<16>(sq); sq = xor32_sum(sq);
                if (fql == 0) xl[(rowl + ai * HALF + m * 16) * 4 + wc] = sq; }
        asm volatile("s_waitcnt lgkmcnt(0)" ::: "memory"); __builtin_amdgcn_s_barrier(); asm volatile("" ::: "memory");
        const f32x4 g0 = *(const f32x4*)(g_kn + colh), g1 = *(const f32x4*)(g_kn + colh + 4);
#pragma unroll
        for (int ai = 0; ai < 2; ++ai)
#pragma unroll
            for (int m = 0; m < 4; ++m) { const f32x4 pp = *(const LAS f32x4*)(xl + (rowl + ai * HALF + m * 16) * 4);
                const float sc = rs[ai][m], rh = rsqrtf(((pp[0] + pp[1]) + (pp[2] + pp[3])) * (1.0f / 128.0f) + EPS);
                const f32x4 k0 = acc[ai][0][m][0] * sc * rh * g0, k1 = acc[ai][0][m][1] * sc * rh * g1;
                u32x4 w; w.x = cvt_pk_bf16(k0[0], k0[1]); w.y = cvt_pk_bf16(k0[2], k0[3]); w.z = cvt_pk_bf16(k1[0], k1[1]); w.w = cvt_pk_bf16(k1[2], k1[3]);
                *(u32x4*)(kf + (size_t)(row0 + ai * HALF + m * 16) * LD_KF + u.pn * 192 + colh) = w; }
    }
};
template <bool GATE> struct EpiResidual {
    const bf16_t* xin; float* xout; bf16_t* xbf; float* ss_out; const float* ss_in; const bf16_t* pp;
    __device__ __forceinline__ void operator()(const f32x4 (&acc)[2][2][4][2], const Unit& u, int wr, int wc, int fr, int fq) const {
        const int row0 = u.pm * BM + wr * 64 + fr, col0 = u.pn * BM + wc * 32 + 8 * fq;
        float rs[2][4];
        if (GATE) load_rstd(ss_in, row0, fq, rs);
#pragma unroll
        for (int ai = 0; ai < 2; ++ai)
#pragma unroll
            for (int m = 0; m < 4; ++m) {
                const int row = row0 + ai * HALF + m * 16;
                const size_t off = (size_t)row * DM + col0;
                float sq = 0.f;
#pragma unroll
                for (int bj = 0; bj < 2; ++bj) {
                    f32x4 d0 = acc[ai][bj][m][0], d1 = acc[ai][bj][m][1];
                    if (GATE) {
                        const u32x4 pw = *(const u32x4*)(pp + off + bj * HALF);
                        const float sc = rs[ai][m];
                        f32x4 p0 = {bf_lo(pw.x), bf_hi(pw.x), bf_lo(pw.y), bf_hi(pw.y)}, p1 = {bf_lo(pw.z), bf_hi(pw.z), bf_lo(pw.w), bf_hi(pw.w)};
#pragma unroll
                        for (int e = 0; e < 4; ++e) { d0[e] = p0[e] * sigm(d0[e] * sc); d1[e] = p1[e] * sigm(d1[e] * sc); }
                    }
                    const u32x4 xw = *(const u32x4*)(xin + off + bj * HALF);
                    const f32x4 x0 = {bf_lo(xw.x), bf_hi(xw.x), bf_lo(xw.y), bf_hi(xw.y)}, x1 = {bf_lo(xw.z), bf_hi(xw.z), bf_lo(xw.w), bf_hi(xw.w)};
                    const f32x4 o0 = x0 + d0, o1 = x1 + d1;
                    if (xout) { *(f32x4*)(xout + off + bj * HALF) = o0; *(f32x4*)(xout + off + bj * HALF + 4) = o1; }
                    u32x4 w; w.x = cvt_pk_bf16(o0[0], o0[1]); w.y = cvt_pk_bf16(o0[2], o0[3]); w.z = cvt_pk_bf16(o1[0], o1[1]); w.w = cvt_pk_bf16(o1[2], o1[3]);
                    *(u32x4*)(xbf + off + bj * HALF) = w;
                    sq += (o0[0] * o0[0] + o0[1] * o0[1]) + (o0[2] * o0[2] + o0[3] * o0[3]) + (o1[0] * o1[0] + o1[1] * o1[1]) + (o1[2] * o1[2] + o1[3] * o1[3]);
                }
                sq += swz_xor<16>(sq); sq = xor32_sum(sq);
                if (fq == 0) ss_out[(size_t)row * 32 + u.pn * 4 + wc] = sq;
            }
    }
};
struct EpiGateUp {
    bf16_t* act; const float* ss; const float* cw; const float* cb; LAS unsigned* xlds; float* edge;
    __device__ __forceinline__ void operator()(const f32x4 (&acc)[2][2][4][2], const Unit& u, int wr, int wc, int fr_, int fq_) const {
        int fr = fr_, fq = fq_; asm volatile("" : "+v"(fr), "+v"(fq));
        const int rl0 = wr * 64 + fr, cl = wc * 32 + 8 * fq, colF = u.pn * 128 + cl;
        float rs[2][4];
        load_rstd(ss, u.pm * BM + rl0, fq, rs);
        const int lane = fq * 16 + fr;
        const int iup = ((lane & 0x30) | ((lane - 1) & 15)) << 2, idn = ((lane & 0x30) | ((lane + 1) & 15)) << 2;
        { const int t = (wr * 4 + wc) * 64 + lane, arr = t >> 7, c = t & 127;
          ((LAS float*)xlds)[512 + t] = (arr < 3) ? cw[(size_t)arr * DFF + u.pn * 128 + c] : cb[u.pn * 128 + c]; }
#define LAUNDER(p) asm volatile("" : "+v"(p))
        GAS bf16_t* pa = (GAS bf16_t*)(act + (size_t)(u.pm * BM + rl0) * DFF + colF);
        unsigned gp[2][4][4];
#pragma unroll
        for (int ai = 0; ai < 2; ++ai)
#pragma unroll
            for (int m = 0; m < 4; ++m) { const f32x4 v0 = acc[ai][0][m][0] * rs[ai][m], v1 = acc[ai][0][m][1] * rs[ai][m];
                gp[ai][m][0] = cvt_pk_bf16(v0[0], v0[1]); gp[ai][m][1] = cvt_pk_bf16(v0[2], v0[3]); gp[ai][m][2] = cvt_pk_bf16(v1[0], v1[1]); gp[ai][m][3] = cvt_pk_bf16(v1[2], v1[3]); }
        if (fr == 0)  { *(LAS u32x4*)(xlds + ((0 * 2 + wr) * 2 + 0) * 64 + (cl >> 1)) = (u32x4){gp[0][0][0], gp[0][0][1], gp[0][0][2], gp[0][0][3]};
                        *(LAS u32x4*)(xlds + ((1 * 2 + wr) * 2 + 0) * 64 + (cl >> 1)) = (u32x4){gp[1][0][0], gp[1][0][1], gp[1][0][2], gp[1][0][3]}; }
        if (fr == 15) { *(LAS u32x4*)(xlds + ((0 * 2 + wr) * 2 + 1) * 64 + (cl >> 1)) = (u32x4){gp[0][3][0], gp[0][3][1], gp[0][3][2], gp[0][3][3]};
                        *(LAS u32x4*)(xlds + ((1 * 2 + wr) * 2 + 1) * 64 + (cl >> 1)) = (u32x4){gp[1][3][0], gp[1][3][1], gp[1][3][2], gp[1][3][3]}; }
        asm volatile("s_waitcnt lgkmcnt(0)" ::: "memory"); __builtin_amdgcn_s_barrier(); asm volatile("" ::: "memory");
#pragma unroll
        for (int ai = 0; ai < 2; ++ai) {
            const bool has_top = (wr == 1) || (ai == 1), has_bot = (wr == 0) || (ai == 0);
            const int tsel = (wr == 1) ? ((ai * 2 + 0) * 2 + 1) : ((0 * 2 + 1) * 2 + 1), bsel = (wr == 0) ? ((ai * 2 + 1) * 2 + 0) : ((1 * 2 + 0) * 2 + 0);
            const u32x4 z4 = {0u, 0u, 0u, 0u};
            const u32x4 topv = has_top ? *(const LAS u32x4*)(xlds + tsel * 64 + (cl >> 1)) : z4, botv = has_bot ? *(const LAS u32x4*)(xlds + bsel * 64 + (cl >> 1)) : z4;
            unsigned ur[4][4], dl[4][4];
#pragma unroll
            for (int m = 0; m < 4; ++m)
#pragma unroll
                for (int j = 0; j < 4; ++j) { ur[m][j] = (unsigned)__builtin_amdgcn_ds_bpermute(iup, (int)gp[ai][m][j]); dl[m][j] = (unsigned)__builtin_amdgcn_ds_bpermute(idn, (int)gp[ai][m][j]); }
            const bool e_first = (ai == 0 && wr == 0 && fr == 0), e_last = (ai == 1 && wr == 1 && fr == 15);
            float* const ep = edge + (size_t)(ai == 0 ? 0 : 3) * (96 * DFF) + (size_t)u.pm * DFF + colF;
#pragma unroll
            for (int m = 0; m < 4; ++m) {
                unsigned opk[4];
#pragma unroll
                for (int j = 0; j < 4; ++j) {
                    const unsigned upw = (fr > 0) ? ur[m][j] : (m > 0 ? ur[m > 0 ? m - 1 : 0][j] : topv[j]);
                    const unsigned dnw = (fr < 15) ? dl[m][j] : (m < 3 ? dl[m < 3 ? m + 1 : 3][j] : botv[j]);
                    const LAS f32x2* wl = (const LAS f32x2*)((const LAS float*)xlds + 512 + cl + 2 * j);
                    const f32x2 w0 = wl[0], w1 = wl[64], w2 = wl[128], bb = wl[192];
                    const float g0 = acc[ai][0][m][j >> 1][2 * (j & 1)] * rs[ai][m], g1 = acc[ai][0][m][j >> 1][2 * (j & 1) + 1] * rs[ai][m];
                    const float u0 = acc[ai][1][m][j >> 1][2 * (j & 1)] * rs[ai][m], u1 = acc[ai][1][m][j >> 1][2 * (j & 1) + 1] * rs[ai][m];
                    const float p0 = w1[0] * g0 + bb[0] + w0[0] * bf_lo(upw) + w2[0] * bf_lo(dnw), p1 = w1[1] * g1 + bb[1] + w0[1] * bf_hi(upw) + w2[1] * bf_hi(dnw);
                    opk[j] = cvt_pk_bf16(p0 * sigm(p0) * u0, p1 * sigm(p1) * u1);
                    if ((m == 0 && e_first) || (m == 3 && e_last)) { ep[2 * j] = p0; ep[2 * j + 1] = p1; ep[96 * DFF + 2 * j] = g0; ep[96 * DFF + 2 * j + 1] = g1; ep[2 * 96 * DFF + 2 * j] = u0; ep[2 * 96 * DFF + 2 * j + 1] = u1; }
                }
                if (!((m == 0 && e_first) || (m == 3 && e_last))) { u32x4 w; w.x = opk[0]; w.y = opk[1]; w.z = opk[2]; w.w = opk[3]; *(GAS u32x4*)pa = w; }
                pa += (size_t)(m == 3 ? 80 : 16) * DFF; LAUNDER(pa);
                __builtin_amdgcn_sched_barrier(0);
            }
        }
#undef LAUNDER
    }
};
}

namespace att {
constexpr int NW = 8, QBLK = 32, KVBLK = 64;
constexpr int SHM_V = 16384, OFF_V = 0, OFF_K = 49152, OFF_WS = 122880, ATT_LDS = 124928;
#define SBAR() __builtin_amdgcn_sched_barrier(0)
__device__ __forceinline__ int crow(int r, int hi) { return (r & 3) + 8 * (r >> 2) + 4 * hi; }
__device__ __forceinline__ void finishSM(f32x16& p0, f32x16& p1, float& l_reg, bf16x8& pa0, bf16x8& pa1, bf16x8& pa2, bf16x8& pa3) {
#pragma unroll
    for (int r = 0; r < 16; ++r) p0[r] = __builtin_amdgcn_exp2f(p0[r]);
#pragma unroll
    for (int r = 0; r < 16; ++r) p1[r] = __builtin_amdgcn_exp2f(p1[r]);
    float ps = 0;
#pragma unroll
    for (int r = 0; r < 16; ++r) ps += p0[r];
#pragma unroll
    for (int r = 0; r < 16; ++r) ps += p1[r];
    l_reg += ps;
#define PK4(P, BASE, OUT) do { unsigned a0 = cvt_pk_bf16(P[BASE + 0], P[BASE + 1]), a1 = cvt_pk_bf16(P[BASE + 2], P[BASE + 3]);   \
    unsigned b0 = cvt_pk_bf16(P[BASE + 4], P[BASE + 5]), b1 = cvt_pk_bf16(P[BASE + 6], P[BASE + 7]);                              \
    u32x4 w = {a0, a1, b0, b1}; OUT = *reinterpret_cast<bf16x8*>(&w); } while (0)
    PK4(p0, 0, pa0); PK4(p0, 8, pa1); PK4(p1, 0, pa2); PK4(p1, 8, pa3);
#undef PK4
}
template <int NQK> struct KB { static constexpr int NB = (NQK == 12) ? 4 : NQK; unsigned a[NB]; };
template <int NQK> __device__ __forceinline__ void kb_init(KB<NQK>& kb, unsigned k_lds_addr, int r32, int hi) {
    constexpr int NB = KB<NQK>::NB; const int f = (NQK == 8) ? (r32 & 15) : ((r32 >> 1) & 7);
#pragma unroll
    for (int k = 0; k < NB; ++k) kb.a[k] = k_lds_addr + (unsigned)(r32 * (NQK * 32) + (((2 * k + hi) ^ f) << 4));
}
__device__ __forceinline__ int v_rd_base(int lane) { return ((lane & 3) << 3) | (((lane >> 2) & 3) << 6) | (((lane >> 4) & 1) << 5) | (((lane >> 5) & 1) << 8); }
constexpr int v_rd_off(int d0, int ks, int half) { return d0 * 512 + ks * 4096 + half * 2048; }
struct NoHook { __device__ __forceinline__ void operator()(f32x16&, f32x16&, int, int) const {} };
struct NaHook {
    const LAS float* bias;
    int kr_lo, rq, rs, c, cs;
    __device__ __forceinline__ void operator()(f32x16& p0, f32x16& p1, int j, int hi) const {
        int t_ = 4 * hi - cs; asm volatile("" : "+v"(t_));
        float ninf; asm volatile("v_mov_b32 %0, 0xff800000" : "=v"(ninf));
        const int kr = kr_lo + j; const bool rowok = (kr >= rs) && (kr < rs + 8);
        const LAS float* bp = bias + ((kr - rq + 7) * 31 - c + 15 + 4 * hi);
#pragma unroll
        for (int r = 0; r < 16; ++r) {
            const int cj = (r & 3) + 8 * (r >> 2);
            const bool ok0 = rowok && ((unsigned)(t_ + cj) < 16u), ok1 = rowok && ((unsigned)(t_ + cj + 32) < 16u);
            const float b0 = bp[cj], b1 = bp[cj + 32];
            p0[r] = ok0 ? fmaf(b0, 1.4426950408889634f, p0[r]) : ninf;
            p1[r] = ok1 ? fmaf(b1, 1.4426950408889634f, p1[r]) : ninf;
        }
    }
};
__device__ __forceinline__ void q_unpack(const bf16x8& q, float (&v)[8]) { const u32x4 w = __builtin_bit_cast(u32x4, q);
    v[0] = bf_lo(w.x); v[1] = bf_hi(w.x); v[2] = bf_lo(w.y); v[3] = bf_hi(w.y); v[4] = bf_lo(w.z); v[5] = bf_hi(w.z); v[6] = bf_lo(w.w); v[7] = bf_hi(w.w); }
__device__ __forceinline__ bf16x8 q_pack(const float (&v)[8]) { const u32x4 w = {cvt_pk_bf16(v[0], v[1]), cvt_pk_bf16(v[2], v[3]), cvt_pk_bf16(v[4], v[5]), cvt_pk_bf16(v[6], v[7])}; return __builtin_bit_cast(bf16x8, w); }
template <int A, int B> __device__ __forceinline__ float q_rstd(const bf16x8* qr) {
    float ss = 0.f;
#pragma unroll
    for (int d0 = A; d0 < B; ++d0) { float v[8]; q_unpack(qr[d0], v);
#pragma unroll
        for (int e = 0; e < 8; ++e) ss = fmaf(v[e], v[e], ss); }
    return rsqrtf(xor32_sum(ss) * (1.0f / (16 * (B - A))) + EPS);
}
__device__ __forceinline__ void q_scale(float (&v)[8], float r, const float* g8, float scale) { const f32x4 g0 = *(const f32x4*)g8 * scale, g1 = *(const f32x4*)(g8 + 4) * scale;
#pragma unroll
    for (int e = 0; e < 4; ++e) { v[e] = v[e] * r * g0[e]; v[e + 4] = v[e + 4] * r * g1[e]; } }
#define QL(x) asm volatile("" : "+v"(x))
#define QDEP(dep, q) do { const unsigned w_ = __builtin_bit_cast(u32x4, q).x; asm volatile("" : "+v"(dep) : "v"(w_)); } while (0)
struct QNone { __device__ __forceinline__ void operator()(bf16x8*, int, int) const {} };
struct QNormNA {
    const float* g; float scale;
    __device__ __forceinline__ void operator()(bf16x8* qr, int, int hi) const {
        const float r = q_rstd<0, 8>(qr); int dep = 0;
#pragma unroll
        for (int d0 = 0; d0 < 8; ++d0) QL(qr[d0]);
#pragma unroll
        for (int d0 = 0; d0 < 8; ++d0) { float v[8]; q_unpack(qr[d0], v); q_scale(v, r, g + 16 * d0 + 8 * hi + dep, scale); qr[d0] = q_pack(v); QDEP(dep, qr[d0]); }
    }
};
struct QNormDiff {
    const float *g, *cosd, *sind; float scale;
    __device__ __forceinline__ void operator()(bf16x8* qr, int trow, int hi) const {
        const float r = q_rstd<0, 4>(qr); int dep = 0;
#pragma unroll
        for (int d0 = 0; d0 < 4; ++d0) QL(qr[d0]);
#pragma unroll
        for (int d0 = 0; d0 < 4; ++d0) { float v[8]; q_unpack(qr[d0], v); q_scale(v, r, g + 16 * d0 + 8 * hi + dep, scale);
            if (d0 == 0) { const f32x4 c0 = *(const f32x4*)(cosd + trow * 8), c1 = *(const f32x4*)(cosd + trow * 8 + 4), s0 = *(const f32x4*)(sind + trow * 8), s1 = *(const f32x4*)(sind + trow * 8 + 4);
#pragma unroll
                for (int e = 0; e < 8; ++e) { const float c = e < 4 ? c0[e & 3] : c1[e & 3], sn = e < 4 ? s0[e & 3] : s1[e & 3];
                    auto rr = __builtin_amdgcn_permlane32_swap(__float_as_uint(v[e]), __float_as_uint(v[e]), false, false);
                    const float p = __uint_as_float(hi ? rr[0] : rr[1]);
                    v[e] = hi ? (p * sn + v[e] * c) : (v[e] * c - p * sn); } }
            qr[d0] = q_pack(v); QDEP(dep, qr[d0]); }
    }
};
struct QNormMLA {
    const float *gn, *gp, *cosm, *sinm; float scale;
    __device__ __forceinline__ void operator()(bf16x8* qr, int trow, int hi) const {
        const float ra = q_rstd<0, 8>(qr), rb = q_rstd<8, 12>(qr); int dep = 0;
#pragma unroll
        for (int d0 = 0; d0 < 12; ++d0) QL(qr[d0]);
#pragma unroll
        for (int d0 = 0; d0 < 8; ++d0) { float v[8]; q_unpack(qr[d0], v); q_scale(v, ra, gn + 16 * d0 + 8 * hi + dep, scale); qr[d0] = q_pack(v); QDEP(dep, qr[d0]); }
#pragma unroll
        for (int k = 0; k < 2; ++k) { float a[8], b[8]; q_unpack(qr[8 + k], a); q_unpack(qr[10 + k], b);
            q_scale(a, rb, gp + 16 * k + 8 * hi + dep, scale); q_scale(b, rb, gp + 32 + 16 * k + 8 * hi + dep, scale);
            const float* cp = cosm + trow * 32 + 16 * k + 8 * hi + dep; const float* sp = sinm + trow * 32 + 16 * k + 8 * hi + dep;
            const f32x4 c0 = *(const f32x4*)cp, c1 = *(const f32x4*)(cp + 4), s0 = *(const f32x4*)sp, s1 = *(const f32x4*)(sp + 4);
#pragma unroll
            for (int e = 0; e < 8; ++e) { const float c = e < 4 ? c0[e & 3] : c1[e & 3], sn = e < 4 ? s0[e & 3] : s1[e & 3];
                const float x = a[e], y = b[e]; a[e] = x * c - y * sn; b[e] = x * sn + y * c; }
            qr[8 + k] = q_pack(a); qr[10 + k] = q_pack(b); QDEP(dep, qr[10 + k]); }
    }
};
#undef QL
#undef QDEP
struct AttnOut { bf16_t* dst; float* scr; float lam; const float* subln; float post; };

template <int I, int N, class F> __device__ __forceinline__ void static_for(F&& f) { if constexpr (I < N) { f(std::integral_constant<int, I>{}); static_for<I + 1, N>(f); } }
template <int OFF> __device__ __forceinline__ bf16x8 dsr128(unsigned a) { bf16x8 r; asm volatile("ds_read_b128 %0, %1 offset:%2" : "=&v"(r) : "v"(a), "i"(OFF) : "memory"); return r; }
template <int OFF> __device__ __forceinline__ s16x4 dstr(unsigned a) { s16x4 r; asm volatile("ds_read_b64_tr_b16 %0, %1 offset:%2" : "=&v"(r) : "v"(a), "i"(OFF) : "memory"); return r; }
template <int N> __device__ __forceinline__ void lgk_wait() { asm volatile("s_waitcnt lgkmcnt(%0)" :: "i"(N) : "memory"); }
template <int NQK, bool DO_QK, bool DO_PV, bool PRE>
__device__ __forceinline__ void mseg(f32x16& S0, f32x16& S1, f32x16* o, const KB<NQK>& kb, int kbufoff, const bf16x8* qr, unsigned vb, bf16x8 pa0, bf16x8 pa1, bf16x8 pa2, bf16x8 pa3, bf16x8 (&kfa)[4]) {
    constexpr int NB = KB<NQK>::NB, NG = NQK / 2, RB = NQK * 32;
    constexpr int NKS = DO_QK ? NG : 0, NVS = DO_PV ? 4 : 0, NST = NKS + NVS;
    bf16x8 kfb[4], kfc[4]; s16x4 vf[3][8];
    unsigned ka[NB];
    if constexpr (DO_QK) {
#pragma unroll
        for (int k = 0; k < NB; ++k) ka[k] = kb.a[k] + (unsigned)kbufoff;
        S0 = f32x16{}; S1 = f32x16{};
    }
    auto issue = [&](auto st) {
        constexpr int ST = decltype(st)::value;
        if constexpr (ST < NKS) {
            constexpr int G = ST, SET = G % 3;
            static_for<0, 2>([&](auto s_) { constexpr int D0 = 2 * G + decltype(s_)::value, SS = decltype(s_)::value;
                const bf16x8 r0 = dsr128<(D0 / NB) * 128>(ka[D0 % NB]), r1 = dsr128<(D0 / NB) * 128 + 32 * RB>(ka[D0 % NB]);
                if constexpr (SET == 0) { kfa[2 * SS] = r0; kfa[2 * SS + 1] = r1; } else if constexpr (SET == 1) { kfb[2 * SS] = r0; kfb[2 * SS + 1] = r1; } else { kfc[2 * SS] = r0; kfc[2 * SS + 1] = r1; } });
        } else {
            constexpr int D0 = ST - NKS, SET = D0 % 3;
            static_for<0, 4>([&](auto ks_) { constexpr int KS = decltype(ks_)::value;
                vf[SET][2 * KS] = dstr<v_rd_off(D0, KS, 0)>(vb); vf[SET][2 * KS + 1] = dstr<v_rd_off(D0, KS, 1)>(vb); });
        }
    };
#define STCNT(st) (((st) >= NST) ? 0 : ((st) < NKS ? 4 : 8))
    if constexpr (!(PRE && DO_QK)) issue(std::integral_constant<int, 0>{});
    if constexpr (NST > 1) issue(std::integral_constant<int, 1>{});
    static_for<0, NST>([&](auto st) {
        constexpr int ST = decltype(st)::value;
        if constexpr (ST + 2 < NST) issue(std::integral_constant<int, ST + 2>{});
        { constexpr int AHEAD = STCNT(ST + 1) + STCNT(ST + 2); lgk_wait<(AHEAD > 15 ? 15 : AHEAD)>(); }
        SBAR();
        if constexpr (ST < NKS) {
            constexpr int G = ST, SET = G % 3;
            static_for<0, 2>([&](auto s_) { constexpr int SS = decltype(s_)::value;
                if constexpr (SET == 0) { S0 = __builtin_amdgcn_mfma_f32_32x32x16_bf16(kfa[2 * SS], qr[2 * G + SS], S0, 0, 0, 0); S1 = __builtin_amdgcn_mfma_f32_32x32x16_bf16(kfa[2 * SS + 1], qr[2 * G + SS], S1, 0, 0, 0); }
                else if constexpr (SET == 1) { S0 = __builtin_amdgcn_mfma_f32_32x32x16_bf16(kfb[2 * SS], qr[2 * G + SS], S0, 0, 0, 0); S1 = __builtin_amdgcn_mfma_f32_32x32x16_bf16(kfb[2 * SS + 1], qr[2 * G + SS], S1, 0, 0, 0); }
                else { S0 = __builtin_amdgcn_mfma_f32_32x32x16_bf16(kfc[2 * SS], qr[2 * G + SS], S0, 0, 0, 0); S1 = __builtin_amdgcn_mfma_f32_32x32x16_bf16(kfc[2 * SS + 1], qr[2 * G + SS], S1, 0, 0, 0); } });
        } else {
            constexpr int D0 = ST - NKS, SET = D0 % 3;
#define VPK(ks) (bf16x8){vf[SET][2 * (ks)][0], vf[SET][2 * (ks)][1], vf[SET][2 * (ks)][2], vf[SET][2 * (ks)][3], vf[SET][2 * (ks) + 1][0], vf[SET][2 * (ks) + 1][1], vf[SET][2 * (ks) + 1][2], vf[SET][2 * (ks) + 1][3]}
            o[D0] = __builtin_amdgcn_mfma_f32_32x32x16_bf16(VPK(0), pa0, o[D0], 0, 0, 0);
            o[D0] = __builtin_amdgcn_mfma_f32_32x32x16_bf16(VPK(1), pa1, o[D0], 0, 0, 0);
            o[D0] = __builtin_amdgcn_mfma_f32_32x32x16_bf16(VPK(2), pa2, o[D0], 0, 0, 0);
            o[D0] = __builtin_amdgcn_mfma_f32_32x32x16_bf16(VPK(3), pa3, o[D0], 0, 0, 0);
#undef VPK
        }
    });
#undef STCNT
}

template <int NQK> __device__ __forceinline__ void kpre(bf16x8 (&kfa)[4], const KB<NQK>& kb, int kbufoff) {
    constexpr int NB = KB<NQK>::NB, RB = NQK * 32;
    static_for<0, 2>([&](auto s_) { constexpr int D0 = decltype(s_)::value; const unsigned ad = kb.a[D0 % NB] + (unsigned)kbufoff;
        kfa[2 * D0] = dsr128<(D0 / NB) * 128>(ad); kfa[2 * D0 + 1] = dsr128<(D0 / NB) * 128 + 32 * RB>(ad); });
}

template <int NQK, int MODE, int ldq, int ldk, int ldv, int LDO, class Hook, class QP>
__device__ __forceinline__ void attn_pp(const bf16_t* __restrict__ Qb, const bf16_t* __restrict__ Kh, const bf16_t* __restrict__ Vh,
                                        int NT, char* lds, const Hook& hook, const AttnOut& out, int wave, const QP& qprep, int t0) {
    constexpr int RB = NQK * 32, KT = 64 * RB, NKP = KT / 4096, NOG = NKP > 4 ? NKP : 4;
    int lane_ = lane_id(); asm volatile("" : "+v"(lane_));
    const int wid = wave, lane = lane_, r32 = lane & 31, hi = lane >> 5, g = wave >> 2, gi = wave & 3;
    char* V_lds = lds + OFF_V; char* K_lds = lds + OFF_K;
    float l_reg = 0; f32x16 o[4] = {}; bf16x8 qr[NQK];
    { const bf16_t* Qw = Qb + (long)(wid * QBLK + r32) * ldq + hi * 8;
#pragma unroll
      for (int d0 = 0; d0 < NQK; ++d0) qr[d0] = *reinterpret_cast<const bf16x8*>(Qw + d0 * 16);
      qprep(qr, t0 + wid * QBLK + r32, hi); }
    unsigned og[NOG];
    if (g == 1) {
#pragma unroll
        for (int i = 0; i < NKP; ++i) { const int off = (gi * NKP + i) * 1024 + lane * 16, row = off / RB, ph = (off % RB) >> 4, f = (NQK == 8) ? (row & 15) : ((row >> 1) & 7);
            og[i] = (unsigned)(row * ldk + (ph ^ f) * 8) * 2u; }
#pragma unroll
        for (int i = NKP; i < NOG; ++i) og[i] = 0u;
    } else {
#pragma unroll
        for (int i = 0; i < 4; ++i) { const int off = (gi * 4 + i) * 1024 + lane * 16, sub = off >> 9, within = (off & 511) >> 1, kk = (sub >> 2) * 8 + (within >> 5), c = (sub & 3) * 32 + (within & 31);
            const int k = kk;
            og[i] = (unsigned)(k * ldv + c) * 2u; }
#pragma unroll
        for (int i = 4; i < NOG; ++i) og[i] = 0u;
    }
    const int vb0 = (int)(uintptr_t)V_lds + v_rd_base(lane);
    KB<NQK> kb; kb_init<NQK>(kb, (unsigned)(uintptr_t)K_lds, r32, hi);
    LAS unsigned char* const kdst = (LAS unsigned char*)(uintptr_t)((unsigned)(uintptr_t)K_lds + (unsigned)(gi * NKP) * 1024u);
    LAS unsigned char* const vdst = (LAS unsigned char*)(uintptr_t)((unsigned)(uintptr_t)V_lds + (unsigned)(gi * 4) * 1024u);
#define DMA_K(t, b) do { const char* kt_ = (const char*)(Kh + (long)(t) * (KVBLK * ldk)); _Pragma("unroll") for (int i_ = 0; i_ < NKP; ++i_) \
    __builtin_amdgcn_global_load_lds((const unsigned*)(kt_ + og[i_]), (LAS unsigned*)(kdst + (b) * KT + i_ * 1024), 16, 0, 0); } while (0)
#define DMA_V(t, b) do { const char* vt_ = (const char*)(Vh + (long)(t) * (KVBLK * ldv)); _Pragma("unroll") for (int i_ = 0; i_ < 4; ++i_) \
    __builtin_amdgcn_global_load_lds((const unsigned*)(vt_ + og[i_]), (LAS unsigned*)(vdst + (b) * SHM_V + i_ * 1024), 16, 0, 0); } while (0)
#define VMW() asm volatile("s_waitcnt vmcnt(0)" ::: "memory")
#define PBAR() do { asm volatile("s_waitcnt lgkmcnt(0)" ::: "memory"); __builtin_amdgcn_s_barrier(); asm volatile("" ::: "memory"); SBAR(); } while (0)
    f32x16 S0, S1; bf16x8 pa0, pa1, pa2, pa3, kfa[4];
    if (g == 0) DMA_V(0, 0); else { DMA_K(0, 0); DMA_K(1, 1); }
    VMW(); PBAR();
    const unsigned vbu = (unsigned)vb0;
    if (g == 0) {
        mseg<NQK, true, false, false>(S0, S1, o, kb, 0, qr, vbu, pa0, pa1, pa2, pa3, kfa); PBAR();
        int vcur = 0, vnext = 1, kn = 1;
        for (int t = 0; t + 1 < NT; ++t) {
            VMW(); DMA_V(t + 1, vnext);
            hook(S0, S1, t, hi); finishSM(S0, S1, l_reg, pa0, pa1, pa2, pa3); kpre<NQK>(kfa, kb, kn * KT); PBAR();
            mseg<NQK, true, true, true>(S0, S1, o, kb, kn * KT, qr, vbu + vcur * SHM_V, pa0, pa1, pa2, pa3, kfa); PBAR();
            vcur = vnext; vnext = (vnext == 2) ? 0 : vnext + 1; kn = (kn == 2) ? 0 : kn + 1;
        }
        VMW(); hook(S0, S1, NT - 1, hi); finishSM(S0, S1, l_reg, pa0, pa1, pa2, pa3); PBAR();
        mseg<NQK, false, true, false>(S0, S1, o, kb, 0, qr, vbu + vcur * SHM_V, pa0, pa1, pa2, pa3, kfa); PBAR();
        PBAR();
    } else {
        if (2 < NT) DMA_K(2, 2); PBAR();
        mseg<NQK, true, false, false>(S0, S1, o, kb, 0, qr, vbu, pa0, pa1, pa2, pa3, kfa); VMW(); PBAR();
        int vcur = 0, kn = 1, kd = 0;
        for (int t = 0; t + 1 < NT; ++t) {
            if (t + 3 < NT) DMA_K(t + 3, kd);
            hook(S0, S1, t, hi); finishSM(S0, S1, l_reg, pa0, pa1, pa2, pa3); kpre<NQK>(kfa, kb, kn * KT); PBAR();
            mseg<NQK, true, true, true>(S0, S1, o, kb, kn * KT, qr, vbu + vcur * SHM_V, pa0, pa1, pa2, pa3, kfa); VMW(); PBAR();
            vcur = (vcur == 2) ? 0 : vcur + 1; kn = (kn == 2) ? 0 : kn + 1; kd = (kd == 2) ? 0 : kd + 1;
        }
        hook(S0, S1, NT - 1, hi); finishSM(S0, S1, l_reg, pa0, pa1, pa2, pa3); PBAR();
        mseg<NQK, false, true, false>(S0, S1, o, kb, 0, qr, vbu + vcur * SHM_V, pa0, pa1, pa2, pa3, kfa); PBAR();
    }
#undef DMA_K
#undef DMA_V
#undef VMW
#undef PBAR
    { auto rr = __builtin_amdgcn_permlane32_swap(__float_as_uint(l_reg), __float_as_uint(l_reg), false, false); l_reg = __uint_as_float(rr[0]) + __uint_as_float(rr[1]); }
    const int lane_e = lane_id(), r32_e = lane_e & 31, hi_e = lane_e >> 5, tid_e = wid * 64 + lane_e;
    const float rl = 1.0f / l_reg;
#define LAUNDER(p) asm volatile("" : "+v"(p))
#define ST8(P, X0, X1, X2, X3, Y0, Y1, Y2, Y3) do { const unsigned a0_ = cvt_pk_bf16(X0, X1), a1_ = cvt_pk_bf16(X2, X3), b0_ = cvt_pk_bf16(Y0, Y1), b1_ = cvt_pk_bf16(Y2, Y3);   \
        auto s0_ = __builtin_amdgcn_permlane32_swap(a0_, b0_, false, false); auto s1_ = __builtin_amdgcn_permlane32_swap(a1_, b1_, false, false);                       \
        u32x4 w_ = {s0_[0], s1_[0], s0_[1], s1_[1]}; *(GAS u32x4*)(P) = w_; } while (0)
    if constexpr (MODE == 0) {
        GAS bf16_t* p = (GAS bf16_t*)(out.dst + (long)(wid * QBLK + r32_e) * LDO + 8 * hi_e);
#pragma unroll
        for (int d0 = 0; d0 < 4; ++d0) {
#pragma unroll
            for (int j = 0; j < 2; ++j)
                ST8(p + d0 * 32 + 16 * j, o[d0][8 * j] * rl, o[d0][8 * j + 1] * rl, o[d0][8 * j + 2] * rl, o[d0][8 * j + 3] * rl, o[d0][8 * j + 4] * rl, o[d0][8 * j + 5] * rl, o[d0][8 * j + 6] * rl, o[d0][8 * j + 7] * rl);
        }
    } else if constexpr (MODE == 1) {
        GAS f32x4* sp = (GAS f32x4*)out.scr + tid_e;
#pragma unroll
        for (int d0 = 0; d0 < 4; ++d0) {
#pragma unroll
            for (int q4 = 0; q4 < 4; ++q4) { f32x4 v = {o[d0][4 * q4] * rl, o[d0][4 * q4 + 1] * rl, o[d0][4 * q4 + 2] * rl, o[d0][4 * q4 + 3] * rl}; sp[(d0 * 4 + q4) * 512] = v; }
        }
    } else {
        GAS bf16_t* p = (GAS bf16_t*)(out.dst + (long)(wid * QBLK + r32_e) * LDO + 8 * hi_e);
        const GAS f32x4* sp = (const GAS f32x4*)out.scr + tid_e;
        const float nl = -out.lam * rl;
        float sq = 0.f;
#pragma unroll
        for (int d0 = 0; d0 < 4; ++d0) {
#pragma unroll
            for (int q4 = 0; q4 < 4; ++q4) { const f32x4 c0 = sp[(d0 * 4 + q4) * 512];
#pragma unroll
                for (int e = 0; e < 4; ++e) { const float v = fmaf(nl, o[d0][4 * q4 + e], c0[e]); o[d0][4 * q4 + e] = v; sq = fmaf(v, v, sq); } }
        }
        sq = xor32_sum(sq);
        const float rs = rsqrtf(sq * (1.0f / 128.0f) + EPS) * out.post;
        const GAS f32x4* gp = (const GAS f32x4*)(out.subln + 4 * hi_e);
#pragma unroll
        for (int d0 = 0; d0 < 4; ++d0) {
#pragma unroll
            for (int j = 0; j < 2; ++j) { const f32x4 g0 = gp[d0 * 8 + 4 * j], g1 = gp[d0 * 8 + 4 * j + 2];
                ST8(p + d0 * 32 + 16 * j, o[d0][8 * j] * rs * g0[0], o[d0][8 * j + 1] * rs * g0[1], o[d0][8 * j + 2] * rs * g0[2], o[d0][8 * j + 3] * rs * g0[3],
                    o[d0][8 * j + 4] * rs * g1[0], o[d0][8 * j + 5] * rs * g1[1], o[d0][8 * j + 6] * rs * g1[2], o[d0][8 * j + 7] * rs * g1[3]); }
        }
    }
#undef ST8
#undef LAUNDER
}
#undef SBAR
}

constexpr size_t MiB = 1u << 20;
constexpr size_t WS_CTL = 0, CTL_ZERO_BYTES = 1 * MiB;
constexpr size_t WS_COSM = 1 * MiB, WS_SINM = 3 * MiB, WS_COSD = 5 * MiB, WS_SIND = 5 * MiB + 512 * 1024;
constexpr size_t WS_SSA = 8 * MiB, WS_SSB = 11 * MiB, WS_SSQ = 14 * MiB;
constexpr size_t WS_WIN = 16 * MiB, WS_WQB = 36 * MiB, WS_WKVB = 37 * MiB, WS_WOUT = 38 * MiB, WS_WGU = 46 * MiB, WS_WDN = 90 * MiB, WS_WPG = 112 * MiB, WS_WPP = 120 * MiB, WS_PB = 121 * MiB;
constexpr size_t WS_XB = 134 * MiB;
constexpr size_t WS_BIG = 230 * MiB;
constexpr size_t WS_PROJ = WS_BIG, WS_QM = WS_BIG + 240 * MiB, WS_KVM = WS_BIG + 288 * MiB, WS_KF = WS_BIG + 348 * MiB, WS_MIX = WS_BIG + 393 * MiB, WS_DSCR = WS_BIG + 489 * MiB;
constexpr size_t WS_GSCR = WS_BIG, WS_EDGE = WS_BIG + 16 * MiB, WS_PP = WS_BIG + 32 * MiB, WS_ACT = WS_BIG + 128 * MiB;
constexpr size_t WS_XB2 = WS_BIG + 521 * MiB;
constexpr size_t WS_W2 = WS_XB2 + 96 * MiB;
constexpr size_t WS_END = WS_W2 + (WS_XB - WS_WIN);
static_assert(WS_WQB >= WS_WIN + (size_t)NPROJ_P * DM * 2 && WS_WGU + (size_t)LD_GU * DM * 2 <= WS_WDN && WS_WDN + (size_t)DM * DFF * 2 <= WS_WPG && WS_PB + (size_t)MROWS * PLE * 2 <= WS_XB, "ws map");
static_assert(WS_PROJ + (size_t)MROWS * NPROJ_P * 2 <= WS_QM && WS_QM + (size_t)MROWS * LD_QM * 2 <= WS_KVM && WS_KVM + (size_t)MROWS * LD_KVM * 2 <= WS_KF && WS_KF + (size_t)MROWS * LD_KF * 2 <= WS_MIX && WS_MIX + (size_t)MROWS * DM * 2 <= WS_DSCR && WS_DSCR + (size_t)32 * MiB <= WS_XB2 && WS_ACT + (size_t)MROWS * DFF * 2 <= WS_MIX, "ws map 2");
static_assert(WS_EDGE + (size_t)6 * 96 * DFF * 4 <= WS_PP && WS_PP + (size_t)MROWS * DM * 2 <= WS_ACT && WS_ACT + (size_t)MROWS * DFF * 2 <= WS_XB2, "ws map 3");

constexpr int CW_BAR = 4096, CW_Q = 16384;

constexpr int NWAVES = 8;
constexpr int RING_OFF = 0, RING_BYTES = 131072;
constexpr int LDSCTL_OFF = RING_BYTES, MISC_OFF = LDSCTL_OFF + 320, BIAS_OFF = LDSCTL_OFF + 1024;
constexpr int XLDS_OFF = LDSCTL_OFF + 4096;
constexpr int LDS_BYTES = 147456;
static_assert(BIAS_OFF + 704 * 4 <= LDS_BYTES && att::ATT_LDS <= RING_BYTES, "LDS map");

#define RLX_AGENT __ATOMIC_RELAXED, __HIP_MEMORY_SCOPE_AGENT

#define XB_TMO      128
#define XB_XCNT(j)  (256  + 64 * (j))
#define XB_XSUB(j)  (1280 + 64 * (j))
#define XB_XGEN(j)  (2304 + 64 * (j))
#define XB_TOP      3328
#define XB_TOPGEN   3392
#define XCD_BAR_WORDS 3456
#define XB_SPIN_CAP (1u << 18)
__device__ __forceinline__ unsigned xb_ld(unsigned* p)              { return __hip_atomic_load(p, __ATOMIC_RELAXED, __HIP_MEMORY_SCOPE_AGENT); }
__device__ __forceinline__ unsigned xb_add(unsigned* p, unsigned v) { return __hip_atomic_fetch_add(p, v, __ATOMIC_RELAXED, __HIP_MEMORY_SCOPE_AGENT); }
__device__ __forceinline__ unsigned xb_xcc_id() { return (unsigned)__builtin_amdgcn_s_getreg((3 << 11) | 20) & 0xFu; }
#define XB_SPIN(cond, bar) do { unsigned _sp = 0; while (cond) { __builtin_amdgcn_s_sleep(1); \
    if ((++_sp & 255u) == 0u) { if (xb_ld(&(bar)[XB_TMO])) break; if (_sp > XB_SPIN_CAP) { atomicAdd(&(bar)[XB_TMO], 1u); break; } } } } while (0)
struct XcdBarrier { unsigned* bar; unsigned x; volatile LAS unsigned* st; int wave; };
__device__ __forceinline__ XcdBarrier xcd_barrier_post(unsigned* bar, volatile LAS unsigned* st) {
    XcdBarrier b; b.bar = bar; b.x = xb_xcc_id(); b.st = st; b.wave = 0;
    if (threadIdx.x == 0) (void)xb_add(&bar[XB_XCNT(b.x)], 1u);
    return b;
}
__device__ __forceinline__ void xcd_barrier_complete(unsigned* bar, unsigned x, unsigned& nloc, unsigned& nx) {
    const unsigned G = gridDim.x * gridDim.y * gridDim.z;
    unsigned sum, cnt, mine, sp = 0u;
    for (;;) {
        sum = 0u; cnt = 0u; mine = 0u;
#pragma unroll
        for (unsigned j = 0; j < 16; ++j) { const unsigned c = xb_ld(&bar[XB_XCNT(j)]); sum += c; cnt += (c > 0u) ? 1u : 0u; mine = (j == x) ? c : mine; }
        if (sum == G) break;
        __builtin_amdgcn_s_sleep(1);
        if ((++sp & 255u) == 0u) { if (xb_ld(&bar[XB_TMO])) break; if (sp > XB_SPIN_CAP) { atomicAdd(&bar[XB_TMO], 1u); break; } }
    }
    nloc = mine > 0u ? mine : 1u; nx = cnt > 0u ? cnt : 1u;
}
__device__ __forceinline__ void xcd_barrier(const XcdBarrier& b) {
    asm volatile("s_waitcnt vmcnt(0)" ::: "memory");
    __syncthreads();
    if (b.wave == 0 && lane_id() == 0) {
        unsigned* bar = b.bar;
        __builtin_amdgcn_s_waitcnt(0);
        unsigned nloc = b.st[0], nx = b.st[1];
        if (nloc == 0u) { xcd_barrier_complete(bar, b.x, nloc, nx); b.st[0] = nloc; b.st[1] = nx; }
        const unsigned old = xb_add(&bar[XB_XSUB(b.x)], 1u);
        const unsigned gen = old / nloc;
        if (old + 1u == (gen + 1u) * nloc) {
            __builtin_amdgcn_fence(__ATOMIC_RELEASE, "agent");
            asm volatile("s_waitcnt vmcnt(0)" ::: "memory");
            const unsigned og = xb_add(&bar[XB_TOP], 1u);
            const unsigned tg = og / nx;
            if (og + 1u == (tg + 1u) * nx) xb_add(&bar[XB_TOPGEN], 1u);
            else XB_SPIN(xb_ld(&bar[XB_TOPGEN]) == tg, bar);
            __builtin_amdgcn_fence(__ATOMIC_ACQUIRE, "agent");
            xb_add(&bar[XB_XGEN(b.x)], 1u);
            asm volatile("s_waitcnt vmcnt(0)" ::: "memory");
        } else {
            XB_SPIN(xb_ld(&bar[XB_XGEN(b.x)]) == gen, bar);
            __builtin_amdgcn_fence(__ATOMIC_ACQUIRE, "agent");
            asm volatile("s_waitcnt vmcnt(0)" ::: "memory");
        }
    }
    __syncthreads();
}

struct Args {
    const float* in[34]; float* out; unsigned char* ws;
    float inv_m[32]; float inv_d[8]; float lam_init[4];
    int ph_lo, ph_hi;
};

struct Frame {
    LAS unsigned char* lds; volatile LAS unsigned* MISC; unsigned* ctl;
    int wave, vcu, G;
};

__device__ __forceinline__ int seq_pos(int row) { return row < SEQ_P ? row : ((row - SEQ_P) & (SEQ_S - 1)); }

__device__ __forceinline__ void transpose_item(const float* W, const float* gain, int K, int N, bf16_t* WT, int row_off, LAS float* scr, int item, int lane, int ilv = 0) {
    const int nblk = N / 32, kb = item / nblk, nb = item % nblk, k0 = 64 * kb, n0 = 32 * nb;
    if (ilv) row_off = (n0 >> 7) * 256 + (n0 & 127) - n0 + (ilv == 2 ? 128 : 0);
    float wv[32];
    { const float* wp = W + (size_t)(k0 + (lane >> 5)) * N + n0 + (lane & 31);
#pragma unroll
      for (int i = 0; i < 32; ++i) wv[i] = wp[(size_t)(2 * i) * N]; }
    { const float g0 = gain ? gain[k0 + (lane & 31) * 2] : 1.f, g1 = gain ? gain[k0 + (lane & 31) * 2 + 1] : 1.f;
#pragma unroll
      for (int i = 0; i < 32; ++i) { const float ga = __int_as_float(__builtin_amdgcn_readlane(__float_as_int(g0), i)), gb = __int_as_float(__builtin_amdgcn_readlane(__float_as_int(g1), i));
          scr[(2 * i + (lane >> 5)) * 33 + (lane & 31)] = wv[i] * ((lane >> 5) ? gb : ga); } }
    asm volatile("s_waitcnt lgkmcnt(0)" ::: "memory");
    const int c = lane & 7;
#pragma unroll
    for (int j = 0; j < 4; ++j) { const int n = (lane >> 3) + 8 * j; const LAS float* s = scr + (8 * c) * 33 + n;
        u32x4 o; o.x = cvt_pk_bf16(s[0 * 33], s[1 * 33]); o.y = cvt_pk_bf16(s[2 * 33], s[3 * 33]); o.z = cvt_pk_bf16(s[4 * 33], s[5 * 33]); o.w = cvt_pk_bf16(s[6 * 33], s[7 * 33]);
        *(u32x4*)(WT + (size_t)(row_off + n0 + n) * K + k0 + 8 * c) = o; }
    asm volatile("s_waitcnt lgkmcnt(0)" ::: "memory");
}

__device__ __forceinline__ void sincos_acc(float ang, float& s, float& c) {
    const double a = (double)ang;
    const double k = rint(a * 0.15915494309189535);
    double rd = fma(-k, 6.283185307179586, a); rd = fma(-k, 2.4492935982947064e-16, rd);
    const float r = (float)rd, r2 = r * r;
    float sp = -1.9572941063391263e-20f;
    sp = fmaf(sp, r2, 8.220635246624329e-18f); sp = fmaf(sp, r2, -2.8114572543455206e-15f); sp = fmaf(sp, r2, 7.647163731819816e-13f); sp = fmaf(sp, r2, -1.6059043836821613e-10f);
    sp = fmaf(sp, r2, 2.505210838544172e-08f); sp = fmaf(sp, r2, -2.7557319223985893e-06f); sp = fmaf(sp, r2, 1.984126984126984e-04f); sp = fmaf(sp, r2, -8.333333333333333e-03f);
    sp = fmaf(sp, r2, 1.6666666666666666e-01f); sp = fmaf(sp, -r2, 1.0f);
    float cp = 8.896791392450574e-22f;
    cp = fmaf(cp, r2, -4.110317623312165e-19f); cp = fmaf(cp, r2, 1.5619206968586225e-16f); cp = fmaf(cp, r2, -4.779477332387385e-14f); cp = fmaf(cp, r2, 1.1470745597729725e-11f);
    cp = fmaf(cp, r2, -2.08767569878681e-09f); cp = fmaf(cp, r2, 2.755731922398589e-07f); cp = fmaf(cp, r2, -2.48015873015873e-05f); cp = fmaf(cp, r2, 1.388888888888889e-03f);
    cp = fmaf(cp, r2, -4.1666666666666664e-02f); cp = fmaf(cp, r2, 0.5f); cp = fmaf(cp, -r2, 1.0f);
    s = sp * r; c = cp;
}

__device__ __forceinline__ float norm64_rope(float v, float gain, int lane, int npair, float c, float s) {
    const float ss = wsum64(v * v);
    v = v * rsqrtf(ss * (1.0f / 64.0f) + EPS) * gain;
    float p;
    if (npair == 32) { auto rr = __builtin_amdgcn_permlane32_swap(__float_as_uint(v), __float_as_uint(v), false, false); p = __uint_as_float(lane < 32 ? rr[1] : rr[0]); }
    else p = swz_xor<8>(v);
    if (lane < 2 * npair) v = (lane < npair) ? (v * c - p * s) : (p * s + v * c);
    return v;
}


constexpr int I_IN = (DM / 64) * (NPROJ / 32), I_QB = (512 / 64) * (960 / 32), I_KVB = (256 / 64) * (1280 / 32), I_OUT = (DM / 64) * (DM / 32), I_G = (DM / 64) * (DFF / 32), I_DN = (DFF / 64) * (DM / 32), I_PP = (PLE / 64) * (DM / 32);
constexpr int NITEMS = I_IN + I_QB + I_KVB + I_OUT + 2 * I_G + I_DN + I_OUT + I_PP;
constexpr int IT_A = I_IN + I_QB + I_KVB + I_OUT, IT_B = IT_A + 2 * I_G;
struct CvtSrc { const float *w_in, *g_mix, *w_qb, *g_cq, *w_kvb, *g_ckv, *w_out, *w_gate, *w_up, *g_ffn, *w_down, *w_pg, *g_ple, *w_pp, *p_p, *p_s; };
__device__ __forceinline__ CvtSrc cvt_src(const Args& a, int LW) {
    CvtSrc c; c.w_in = a.in[5] + (size_t)LW * DM * NPROJ; c.g_mix = a.in[4] + LW * DM; c.w_qb = a.in[10] + (size_t)LW * 512 * 960; c.g_cq = a.in[9] + LW * 512; c.w_kvb = a.in[12] + (size_t)LW * 256 * 1280; c.g_ckv = a.in[11] + LW * 256;
    c.w_out = a.in[24] + (size_t)LW * DM * DM; c.w_gate = a.in[26] + (size_t)LW * DM * DFF; c.w_up = a.in[27] + (size_t)LW * DM * DFF; c.g_ffn = a.in[25] + LW * DM;
    c.w_down = a.in[30] + (size_t)LW * DFF * DM; c.w_pg = a.in[32] + (size_t)LW * DM * DM; c.g_ple = a.in[31] + LW * DM; c.w_pp = a.in[33] + (size_t)LW * PLE * DM;
    c.p_p = a.in[2] + (size_t)LW * SEQ_P * PLE; c.p_s = a.in[3] + (size_t)LW * 2 * SEQ_S * PLE; return c;
}
__device__ __forceinline__ void cvt_item(const CvtSrc c, int it, unsigned char* wbase, LAS float* scr, int lane) {
    int r = it;
    if (r < I_IN) { transpose_item(c.w_in, c.g_mix, DM, NPROJ, (bf16_t*)(wbase + WS_WIN), 0, scr, r, lane); return; } r -= I_IN;
    if (r < I_QB) { transpose_item(c.w_qb, c.g_cq, 512, 960, (bf16_t*)(wbase + WS_WQB), 0, scr, r, lane); return; } r -= I_QB;
    if (r < I_KVB) { transpose_item(c.w_kvb, c.g_ckv, 256, 1280, (bf16_t*)(wbase + WS_WKVB), 0, scr, r, lane); return; } r -= I_KVB;
    if (r < I_OUT) { transpose_item(c.w_out, nullptr, DM, DM, (bf16_t*)(wbase + WS_WOUT), 0, scr, r, lane); return; } r -= I_OUT;
    if (r < I_G) { transpose_item(c.w_gate, c.g_ffn, DM, DFF, (bf16_t*)(wbase + WS_WGU), 0, scr, r, lane, 1); return; } r -= I_G;
    if (r < I_G) { transpose_item(c.w_up, c.g_ffn, DM, DFF, (bf16_t*)(wbase + WS_WGU), 0, scr, r, lane, 2); return; } r -= I_G;
    if (r < I_DN) { transpose_item(c.w_down, nullptr, DFF, DM, (bf16_t*)(wbase + WS_WDN), 0, scr, r, lane); return; } r -= I_DN;
    if (r < I_OUT) { transpose_item(c.w_pg, c.g_ple, DM, DM, (bf16_t*)(wbase + WS_WPG), 0, scr, r, lane); return; } r -= I_OUT;
    transpose_item(c.w_pp, nullptr, PLE, DM, (bf16_t*)(wbase + WS_WPP), 0, scr, r, lane);
}
__device__ __forceinline__ void cvt_prow(const CvtSrc c, int m, unsigned char* wbase, int lane) {
    const float* src = (m < SEQ_P) ? c.p_p + (size_t)m * PLE : c.p_s + (size_t)(m - SEQ_P) * PLE;
    const f32x4 v = ((const f32x4*)src)[lane]; u32x2 w; w.x = cvt_pk_bf16(v[0], v[1]); w.y = cvt_pk_bf16(v[2], v[3]); ((u32x2*)((bf16_t*)(wbase + WS_PB) + (size_t)m * PLE))[lane] = w;
}

__global__ void __launch_bounds__(NWAVES * 64, 2) enc_fwd(Args args) {
    extern __shared__ __attribute__((aligned(16))) unsigned char lds[];
    Frame F;
    F.lds = (LAS unsigned char*)lds;
    F.MISC = (volatile LAS unsigned*)(F.lds + MISC_OFF);
    F.wave = __builtin_amdgcn_readfirstlane((int)threadIdx.x >> 6);
    F.G = gridDim.x; { const int bx = blockIdx.x; F.vcu = (F.G % 8 == 0) ? (bx % 8) * (F.G / 8) + bx / 8 : bx; }
    unsigned char* ws = args.ws;
    F.ctl = (unsigned*)(ws + WS_CTL);
    for (int u = threadIdx.x; u < (LDS_BYTES - LDSCTL_OFF) / 4; u += NWAVES * 64) ((LAS unsigned*)(F.lds + LDSCTL_OFF))[u] = 0u;
    __syncthreads();
#if MK_SPLIT
    XcdBarrier bar; bar.bar = nullptr; bar.x = 0; bar.st = nullptr; bar.wave = 0;
#define GRID_BAR() do { } while (0)
#else
    XcdBarrier bar = xcd_barrier_post(F.ctl + CW_BAR, F.MISC + 8); bar.wave = F.wave;
#define GRID_BAR() xcd_barrier(bar)
#endif
    const int lo = args.ph_lo, hi = args.ph_hi;
#define IN(k) (lo <= (k) && (k) < hi)
#define SEAM(k) do { if (IN((k) + 1)) GRID_BAR(); } while (0)

#define COSM ((float*)(wsl + WS_COSM))
#define SINM ((float*)(wsl + WS_SINM))
#define COSD ((float*)(wsl + WS_COSD))
#define SIND ((float*)(wsl + WS_SIND))
#define SSA ((float*)(wsl + WS_SSA))
#define SSB ((float*)(wsl + WS_SSB))
#define SSQ ((float*)(wsl + WS_SSQ))
#define WIN_L(LW) ((bf16_t*)(wsl + WS_WIN + (((LW) & 1) ? (WS_W2 - WS_WIN) : 0)))
#define WIN WIN_L(L)
#define WQB_L(LW) ((bf16_t*)(wsl + WS_WQB + (((LW) & 1) ? (WS_W2 - WS_WIN) : 0)))
#define WQB WQB_L(L)
#define WKVB_L(LW) ((bf16_t*)(wsl + WS_WKVB + (((LW) & 1) ? (WS_W2 - WS_WIN) : 0)))
#define WKVB WKVB_L(L)
#define WOUT_L(LW) ((bf16_t*)(wsl + WS_WOUT + (((LW) & 1) ? (WS_W2 - WS_WIN) : 0)))
#define WOUT WOUT_L(L)
#define WGU_L(LW) ((bf16_t*)(wsl + WS_WGU + (((LW) & 1) ? (WS_W2 - WS_WIN) : 0)))
#define WGU WGU_L(L)
#define WDN_L(LW) ((bf16_t*)(wsl + WS_WDN + (((LW) & 1) ? (WS_W2 - WS_WIN) : 0)))
#define WDN WDN_L(L)
#define WPG_L(LW) ((bf16_t*)(wsl + WS_WPG + (((LW) & 1) ? (WS_W2 - WS_WIN) : 0)))
#define WPG WPG_L(L)
#define WPP_L(LW) ((bf16_t*)(wsl + WS_WPP + (((LW) & 1) ? (WS_W2 - WS_WIN) : 0)))
#define WPP WPP_L(L)
#define PB_L(LW) ((bf16_t*)(wsl + WS_PB + (((LW) & 1) ? (WS_W2 - WS_WIN) : 0)))
#define PB PB_L(L)
#define XB ((bf16_t*)(wsl + ((L & 1) ? WS_XB2 : WS_XB)))
#define XBN ((bf16_t*)(wsl + ((L & 1) ? WS_XB : WS_XB2)))
#define PROJ ((bf16_t*)(wsl + WS_PROJ))
#define QM ((bf16_t*)(wsl + WS_QM))
#define KVM ((bf16_t*)(wsl + WS_KVM))
#define KF ((bf16_t*)(wsl + WS_KF))
#define MIX ((bf16_t*)(wsl + WS_MIX))
#define DSCR ((float*)(wsl + WS_DSCR))
#define EDGE ((float*)(wsl + WS_EDGE))
#define ACT ((bf16_t*)(wsl + WS_ACT))
#define PP ((bf16_t*)(wsl + WS_PP))
#define PHASE_BEGIN() size_t wso_ = 0; asm volatile("" : "+s"(wso_)); unsigned char* wsl = ws + wso_; int lane = lane_id(); asm volatile("" : "+v"(lane)); const int ptid = F.wave * 64 + lane; (void)lane; (void)ptid; (void)wsl
#define XOUT (args.out)
#define gw (F.vcu * NWAVES + F.wave)
#define NGW (F.G * NWAVES)
#define NGT (F.G * NWAVES * 64)


#define NEXT_UNIT(ctr, uvar) do { if (F.wave == 0 && lane_id() == 0) F.MISC[12] = __hip_atomic_fetch_add((ctr), 1u, RLX_AGENT); __syncthreads(); uvar = __builtin_amdgcn_readfirstlane((int)F.MISC[12]); __syncthreads(); } while (0)
#define CVT_QUEUE(ctr, first, n_items, with_prows, LW) do { \
        constexpr int nch_t_ = ((n_items) + 63) / 64, nch_ = nch_t_ + ((with_prows) ? MROWS / 512 : 0); \
        LAS float* scr_ = (LAS float*)(F.lds + RING_OFF + F.wave * 16384); \
        const CvtSrc cs_ = cvt_src(args, (LW)); unsigned char* wb_ = wsl + ((((LW)) & 1) ? (WS_W2 - WS_WIN) : 0); \
        for (;;) { int c_; NEXT_UNIT((ctr), c_); if (c_ >= nch_) break; \
            const int lane_ = lane_id(); \
            if (c_ < nch_t_) { for (int k_ = 0; k_ < 8; ++k_) { const int it_ = c_ * 64 + F.wave * 8 + k_; if (it_ < (n_items)) cvt_item(cs_, (first) + it_, wb_, scr_, lane_); } } \
            else { for (int k_ = 0; k_ < 64; ++k_) cvt_prow(cs_, (c_ - nch_t_) * 512 + F.wave * 64 + k_, wb_, lane_); } } } while (0)
#define CVT_CTR(L_, k_) (F.ctl + CW_Q + 64 * (48 + 2 * (L_) + (k_)))
    for (int L = 0; L < NLAYER; ++L) {
        const int pb = 11 * L;
        if (PH_ON(0) && IN(pb + 0) && (L == 0 || !CVT_AHEAD)) {
            PHASE_BEGIN();
            for (int rep = 0; rep < NREP(0); ++rep) { if (rep) GRID_BAR();

            LAS float* scr = (LAS float*)(F.lds + RING_OFF + F.wave * 16384);
            { const CvtSrc cs = cvt_src(args, L); unsigned char* wb = wsl + ((L & 1) ? (WS_W2 - WS_WIN) : 0);
              for (int it = gw; it < (CVT_AHEAD ? IT_A : NITEMS); it += NGW) cvt_item(cs, it, wb, scr, lane);
              if (!CVT_AHEAD) for (int m = gw; m < MROWS; m += NGW) cvt_prow(cs, m, wb, lane); }
            if (L == 0) {
                for (int i = F.vcu * (NWAVES * 64) + ptid; i < SEQ_P * 32; i += NGT) { const int t = i >> 5, k = i & 31; float s, c; sincos_acc((float)t * args.inv_m[k], s, c); COSM[i] = c; SINM[i] = s; }
                for (int i = F.vcu * (NWAVES * 64) + ptid; i < SEQ_P * 8; i += NGT) { const int t = i >> 3, k = i & 7; float s, c; sincos_acc((float)t * args.inv_d[k], s, c); COSD[i] = c; SIND[i] = s; }
                for (int m = gw; m < MROWS; m += NGW) { const float* src = (m < SEQ_P) ? args.in[0] + (size_t)m * DM : args.in[1] + (size_t)(m - SEQ_P) * DM;
                    float ss = 0.f;
#pragma unroll
                    for (int j = 0; j < 8; ++j) { const f32x4 v = ((const f32x4*)src)[j * 64 + lane]; ss += (v[0] * v[0] + v[1] * v[1]) + (v[2] * v[2] + v[3] * v[3]);
                        u32x2 w; w.x = cvt_pk_bf16(v[0], v[1]); w.y = cvt_pk_bf16(v[2], v[3]); ((u32x2*)(XB + (size_t)m * DM))[j * 64 + lane] = w; }
                    ss = wsum64(ss);
                    if (lane < 32) SSA[(size_t)m * 32 + lane] = (lane == 0) ? ss : 0.f; }
            }
            }
            SEAM(pb + 0);
        }
        if (PH_ON(1) && IN(pb + 1)) {
            PHASE_BEGIN();
            for (int rep = 0; rep < NREP(1); ++rep) { if (rep) GRID_BAR();

            pg8::Gemm g{XB, WIN, MROWS, NPROJ_P, DM, DM}; pg8::StaticOrder S; S.init(MROWS, NPROJ_P, F.G, (int)blockIdx.x);
            pg8::EpiScaleBf16<true> E{PROJ, NPROJ_P, SSA, SSQ};
            pg8::gemm_phase(F.lds + RING_OFF, g, S, E, F.wave);
            }
            if (CVT_AHEAD && NREP(1) == 1) { PHASE_BEGIN(); CVT_QUEUE(CVT_CTR(L, 0), IT_A, IT_B - IT_A, false, L); }
            SEAM(pb + 1);
        }
        if (PH_ON(2) && IN(pb + 2)) {
            PHASE_BEGIN();
            { const float* g_nak = args.in[7] + L * 128; const float* g_kpe = args.in[16] + L * 64; const float* g_dk = args.in[18] + L * 64;
            for (int m2 = gw * 2; m2 < MROWS; m2 += NGW * 2) {
                unsigned wna[2][6]; bf16_t wdf[2][10], wkpe[2]; float cm[2], sm[2], cd[2], sd[2];
#pragma unroll
                for (int rr = 0; rr < 2; ++rr) { const int m = m2 + rr; const bf16_t* pr = PROJ + (size_t)m * NPROJ_P; const int t = seq_pos(m);
#pragma unroll
                    for (int s = 0; s < 6; ++s) wna[rr][s] = ((const unsigned*)(pr + C_NAK + s * 128))[lane];
                    wkpe[rr] = pr[C_KPE + lane];
#pragma unroll
                    for (int s = 0; s < 10; ++s) wdf[rr][s] = pr[C_DFK + s * 64 + lane];
                    cm[rr] = COSM[t * 32 + (lane & 31)]; sm[rr] = SINM[t * 32 + (lane & 31)]; cd[rr] = COSD[t * 8 + (lane & 7)]; sd[rr] = SIND[t * 8 + (lane & 7)]; }
                const f32x2 gk = ((const f32x2*)g_nak)[lane]; const float gkp = g_kpe[lane], gdk = g_dk[lane];
                asm volatile("" ::: "memory");
#pragma unroll
                for (int rr = 0; rr < 2; ++rr) {
#pragma unroll
                    for (int s = 0; s < 6; ++s) { const float a = bf_lo(wna[rr][s]), b = bf_hi(wna[rr][s]);
                        const float r = rsqrtf(wsum64(a * a + b * b) * (1.0f / 128.0f) + EPS);
                        wna[rr][s] = cvt_pk_bf16(a * r * gk[0], b * r * gk[1]); }
                    wkpe[rr] = f2bf(norm64_rope(bf2f(wkpe[rr]), gkp, lane, 32, cm[rr], sm[rr]));
#pragma unroll
                    for (int s = 0; s < 10; ++s) wdf[rr][s] = f2bf(norm64_rope(bf2f(wdf[rr][s]), gdk, lane, 8, cd[rr], sd[rr])); }
                asm volatile("" ::: "memory");
#pragma unroll
                for (int rr = 0; rr < 2; ++rr) { const int m = m2 + rr; bf16_t* pr = PROJ + (size_t)m * NPROJ_P; bf16_t* kf = KF + (size_t)m * LD_KF;
#pragma unroll
                    for (int s = 0; s < 6; ++s) ((unsigned*)(pr + C_NAK + s * 128))[lane] = wna[rr][s];
#pragma unroll
                    for (int h = 0; h < 5; ++h) kf[h * 192 + 128 + lane] = wkpe[rr];
#pragma unroll
                    for (int s = 0; s < 10; ++s) pr[C_DFK + s * 64 + lane] = wdf[rr][s]; }
            } }
            asm volatile("s_waitcnt vmcnt(0) lgkmcnt(0)" ::: "memory"); __syncthreads();
            int kq = 512, kkv = 256; asm volatile("" : "+s"(kq), "+s"(kkv));
            { PHASE_BEGIN(); pg8::Gemm g{PROJ + C_CQ, WQB, MROWS, 1024, kq, NPROJ_P}; pg8::StaticOrder S; S.init(MROWS, 1024, F.G, (int)blockIdx.x);
              pg8::EpiScaleLat<8, 512> E{QM, LD_QM, SSQ}; pg8::gemm_phase(F.lds + RING_OFF, g, S, E, F.wave); }
            { PHASE_BEGIN(); pg8::Gemm g{PROJ + C_CKV, WKVB, MROWS, 1280, kkv, NPROJ_P}; pg8::StaticOrder S; S.init(MROWS, 1280, F.G, (int)blockIdx.x);
              pg8::EpiKvm E{KVM, KF, SSQ + 8, args.in[15] + L * 128, (LAS float*)(F.lds + XLDS_OFF)}; pg8::gemm_phase(F.lds + RING_OFF, g, S, E, F.wave); }
            SEAM(pb + 4);
        }
        if (PH_ON(5) && IN(pb + 5)) {
            PHASE_BEGIN();
            for (int rep = 0; rep < NREP(5); ++rep) { if (rep) GRID_BAR();

            char* alds = (char*)lds + RING_OFF;
            unsigned* qctr = F.ctl + CW_Q + 64 * (L * 6) + rep * 64 * 24;
#pragma unroll 1
            for (int pass = 0; pass < 2; ++pass) {
            const int ubase = pass ? 320 : 0, ucnt = pass ? 160 : 320;
            if (PH_ON(11)) {
                float lam;
                { const int lane = lane_id(); const float a = wsum64((args.in[19] + L * 64)[lane] * (args.in[20] + L * 64)[lane]); const float b = wsum64((args.in[21] + L * 64)[lane] * (args.in[22] + L * 64)[lane]);
                  lam = expf(a) - expf(b) + args.lam_init[L]; }
                float* scr = DSCR + (size_t)blockIdx.x * (64 * 512);
                for (;;) {
                    int u; NEXT_UNIT(qctr + 64 * (2 * pass), u); if (u >= ucnt) break; u += ubase;
                    int h, row0, kbase, nkeys;
                    if (u < 320) { h = u / 64; row0 = (u % 64) * 256; kbase = 0; nkeys = SEQ_P; }
                    else { const int v = u - 320; h = v / 32; const int w = v % 32; kbase = SEQ_P + (w / 16) * SEQ_S; row0 = kbase + (w % 16) * 256; nkeys = SEQ_S; }
                    att::AttnOut o0{nullptr, scr, 0.f, nullptr, 0.f};
                    const att::QNormDiff qn{args.in[17] + L * 64, COSD, SIND, 0.18033688011112042f  };
                    att::attn_pp<4, 1, NPROJ_P, NPROJ_P, NPROJ_P, DM, att::NoHook>(PROJ + (size_t)row0 * NPROJ_P + C_DFQ + h * 128, PROJ + (size_t)kbase * NPROJ_P + C_DFK + h * 128,
                                                         PROJ + (size_t)kbase * NPROJ_P + C_DFV + h * 128, nkeys / 64, alds, att::NoHook{}, o0, F.wave, qn, row0 - kbase);
                    att::AttnOut o1{MIX + (size_t)row0 * DM + 1408 + h * 128, scr, lam, args.in[23] + L * 128, 1.0f - args.lam_init[L]};
                    att::attn_pp<4, 2, NPROJ_P, NPROJ_P, NPROJ_P, DM, att::NoHook>(PROJ + (size_t)row0 * NPROJ_P + C_DFQ + h * 128 + 64, PROJ + (size_t)kbase * NPROJ_P + C_DFK + h * 128 + 64,
                                                         PROJ + (size_t)kbase * NPROJ_P + C_DFV + h * 128, nkeys / 64, alds, att::NoHook{}, o1, F.wave, qn, row0 - kbase);
                }
            }
            if (PH_ON(12)) for (;;) {
                int u; NEXT_UNIT(qctr + 64 * (2 * pass + 1), u); if (u >= ucnt) break; u += ubase;
                int h, row0, kbase, nkeys;
                if (u < 320) { h = u / 64; row0 = (u % 64) * 256; kbase = 0; nkeys = SEQ_P; }
                else { const int v = u - 320; h = v / 32; const int w = v % 32; kbase = SEQ_P + (w / 16) * SEQ_S; row0 = kbase + (w % 16) * 256; nkeys = SEQ_S; }
                att::AttnOut o0{MIX + (size_t)row0 * DM + 768 + h * 128, nullptr, 0.f, nullptr, 0.f};
                att::attn_pp<12, 0, LD_QM, LD_KF, LD_KVM, DM, att::NoHook>(QM + (size_t)row0 * LD_QM + h * 192, KF + (size_t)kbase * LD_KF + h * 192,
                                                      KVM + (size_t)kbase * LD_KVM + h * 256 + 128, nkeys / 64, alds, att::NoHook{}, o0, F.wave,
                                                      att::QNormMLA{args.in[13] + L * 128, args.in[14] + L * 64, COSM, SINM, 0.10411754627697264f  }, row0 - kbase);
            }
            }
            if (PH_ON(13)) for (;;) {
                int u; NEXT_UNIT(qctr + 64 * 4, u); if (u >= 576) break;
                int h, sbase, rows, r0;
                if (u < 384) { h = u / 64; sbase = 0; rows = 256; r0 = (u % 64) * 4; }
                else { const int v = u - 384; h = v / 32; const int w = v % 32; sbase = SEQ_P + (w / 16) * SEQ_S; rows = 64; r0 = (w % 16) * 4; }
                LAS float* btab = (LAS float*)(F.lds + BIAS_OFF);
                const int lane = lane_id();
                { const int ptid = F.wave * 64 + lane; const float* rpb = args.in[8] + (size_t)(L * 6 + h) * 465; if (ptid < 465) btab[48 + ptid] = rpb[ptid]; }
                int kr_lo = r0 - 4; kr_lo = kr_lo < 0 ? 0 : (kr_lo > rows - 11 ? rows - 11 : kr_lo);
                att::NaHook hook; hook.bias = (const LAS float*)(F.lds + BIAS_OFF) + 48; hook.kr_lo = kr_lo; hook.rq = r0 + (F.wave >> 1);
                { int rs = hook.rq - 4; rs = rs < 0 ? 0 : (rs > rows - 8 ? rows - 8 : rs); hook.rs = rs; }
                hook.c = 32 * (F.wave & 1) + (lane & 31); { int cs = hook.c - 8; cs = cs < 0 ? 0 : (cs > 48 ? 48 : cs); hook.cs = cs; }
                const size_t row0 = (size_t)sbase + (size_t)r0 * 64, krow0 = (size_t)sbase + (size_t)kr_lo * 64;
                att::AttnOut o0{MIX + row0 * DM + h * 128, nullptr, 0.f, nullptr, 0.f};
                att::attn_pp<8, 0, NPROJ_P, NPROJ_P, NPROJ_P, DM, att::NaHook>(PROJ + row0 * NPROJ_P + C_NAQ + h * 128, PROJ + krow0 * NPROJ_P + C_NAK + h * 128,
                                                     PROJ + krow0 * NPROJ_P + C_NAV + h * 128, 11, alds, hook, o0, F.wave, att::QNormNA{args.in[6] + L * 128, 0.12751743082459868f  }, 0);
            }
            if (CVT_AHEAD && L + 1 < NLAYER && NREP(5) == 1) CVT_QUEUE(qctr + 64 * 5, 0, IT_A, false, L + 1);
            }
            SEAM(pb + 5);
        }
        if (PH_ON(6) && IN(pb + 6)) {
            PHASE_BEGIN();
            pg8::Gemm g{MIX, WOUT, MROWS, DM, DM, DM}; pg8::StaticOrder S; S.init(MROWS, DM, F.G, (int)blockIdx.x);
            pg8::EpiResidual<false> E; E.xin = XB; E.xout = nullptr; E.xbf = XB; E.ss_out = SSA; E.ss_in = nullptr; E.pp = nullptr;
            pg8::gemm_phase(F.lds + RING_OFF, g, S, E, F.wave);
            SEAM(pb + 6);
        }
        if (PH_ON(7) && IN(pb + 7)) {
            PHASE_BEGIN();
            for (int rep = 0; rep < NREP(7); ++rep) { if (rep) GRID_BAR();

            pg8::Gemm g{XB, WGU, MROWS, LD_GU, DM, DM}; pg8::StaticOrder S; S.init(MROWS, LD_GU, F.G, (int)blockIdx.x);
            pg8::EpiGateUp E{ACT, SSA, args.in[28] + (size_t)L * 3 * DFF, args.in[29] + (size_t)L * DFF, (LAS unsigned*)(F.lds + XLDS_OFF), EDGE};
            pg8::gemm_phase(F.lds + RING_OFF, g, S, E, F.wave);
            }
            if (CVT_AHEAD && NREP(7) == 1) { PHASE_BEGIN(); CVT_QUEUE(CVT_CTR(L, 1), IT_B, NITEMS - IT_B, true, L); }
            SEAM(pb + 7);
        }
        if (PH_ON(8) && IN(pb + 8)) {
            PHASE_BEGIN();
            for (int rep = 0; rep < NREP(8); ++rep) { if (rep) GRID_BAR();

            const float* cw = args.in[28] + (size_t)L * 3 * DFF;
            const float* PF = EDGE; const float* GF = EDGE + 96 * DFF; const float* UF = EDGE + 2 * 96 * DFF; const float* PL = EDGE + 3 * 96 * DFF; const float* GL = EDGE + 4 * 96 * DFF; const float* UL = EDGE + 5 * 96 * DFF;
            for (int i = F.vcu * (NWAVES * 64) + ptid; i < 2 * 96 * (DFF / 4); i += NGT) {
                const int which = i / (96 * (DFF / 4)), j = i % (96 * (DFF / 4)), pm = j / (DFF / 4), c4 = (j % (DFF / 4)) * 4;
                const int row = pm * 256 + (which ? 255 : 0); const int t = seq_pos(row), slen = row < SEQ_P ? SEQ_P : SEQ_S;
                f32x4 pre = *(const f32x4*)((which ? PL : PF) + (size_t)pm * DFF + c4); const f32x4 uu = *(const f32x4*)((which ? UL : UF) + (size_t)pm * DFF + c4);
                if (which == 0 && t > 0) pre += *(const f32x4*)(cw + c4) * *(const f32x4*)(GL + (size_t)(pm - 1) * DFF + c4);
                if (which == 1 && t < slen - 1) pre += *(const f32x4*)(cw + 2 * DFF + c4) * *(const f32x4*)(GF + (size_t)(pm + 1) * DFF + c4);
                float o[4];
#pragma unroll
                for (int e = 0; e < 4; ++e) o[e] = pre[e] * sigm(pre[e]) * uu[e];
                u32x2 w; w.x = cvt_pk_bf16(o[0], o[1]); w.y = cvt_pk_bf16(o[2], o[3]);
                *(u32x2*)(ACT + (size_t)row * DFF + c4) = w;
            }
            }
            SEAM(pb + 8);
        }
        if (PH_ON(9) && IN(pb + 9)) {
            PHASE_BEGIN();
            { pg8::Gemm g{ACT, WDN, MROWS, DM, DFF, DFF}; pg8::StaticOrder S; S.init(MROWS, DM, F.G, (int)blockIdx.x);
              pg8::EpiResidual<false> E; E.xin = XB; E.xout = nullptr; E.xbf = XB; E.ss_out = SSB; E.ss_in = nullptr; E.pp = nullptr;
              pg8::gemm_phase(F.lds + RING_OFF, g, S, E, F.wave); }
            { PHASE_BEGIN(); int kp = PLE; asm volatile("" : "+s"(kp)); pg8::Gemm g{PB, WPP, MROWS, DM, kp, PLE};   pg8::StaticOrder S; S.init(MROWS, DM, F.G, (int)blockIdx.x);
              pg8::EpiScaleBf16<false> E{PP, DM, nullptr}; pg8::gemm_phase(F.lds + RING_OFF, g, S, E, F.wave); }
            SEAM(pb + 9);
        }
        if (PH_ON(10) && IN(pb + 10)) {
            PHASE_BEGIN();
            pg8::Gemm g{XB, WPG, MROWS, DM, DM, DM}; pg8::StaticOrder S; S.init(MROWS, DM, F.G, (int)blockIdx.x);
            pg8::EpiResidual<true> E; E.xin = XB; E.xout = (L == NLAYER - 1) ? XOUT : nullptr; E.xbf = XBN; E.ss_out = SSA; E.ss_in = SSB; E.pp = PP;
            pg8::gemm_phase(F.lds + RING_OFF, g, S, E, F.wave);
            SEAM(pb + 10);
        }
    }
#undef IN
#undef SEAM
#undef GRID_BAR
}

extern "C" void kernel_launch(void* const* d_in, const int* in_sizes, int n_in, void* d_out, int out_size, void* d_ws, size_t ws_size, hipStream_t stream) {
    static int grid = 0;
    if (grid == 0) {
        if (n_in != 34 || out_size != MROWS * DM || ws_size < WS_END) { fprintf(stderr, "kernel_launch: unexpected shapes: n_in %d out %d ws %zu (need %zu)\n", n_in, out_size, ws_size, (size_t)WS_END); grid = -1; return; }
        int dev = 0, cus = 0, per_cu = 0;
        if (hipGetDevice(&dev) != hipSuccess || hipDeviceGetAttribute(&cus, hipDeviceAttributeMultiprocessorCount, dev) != hipSuccess) { grid = -1; return; }
        if (hipFuncSetAttribute((const void*)enc_fwd, hipFuncAttributeMaxDynamicSharedMemorySize, LDS_BYTES) != hipSuccess) { fprintf(stderr, "kernel_launch: hipFuncSetAttribute failed\n"); grid = -1; return; }
        if (hipOccupancyMaxActiveBlocksPerMultiprocessor(&per_cu, (const void*)enc_fwd, NWAVES * 64, LDS_BYTES) != hipSuccess || per_cu < 1)
            fprintf(stderr, "kernel_launch: occupancy query reports %d workgroups per CU\n", per_cu);
        (void)hipGetLastError();
        grid = cus;
    }
    if (grid < 0) return;
    if (hipMemsetAsync((char*)d_ws + WS_CTL, 0, CTL_ZERO_BYTES, stream) != hipSuccess) { fprintf(stderr, "kernel_launch: memset failed\n"); return; }
    Args a{};
    for (int i = 0; i < 34; ++i) a.in[i] = (const float*)d_in[i];
    a.out = (float*)d_out; a.ws = (unsigned char*)d_ws;
    for (int i = 0; i < 32; ++i) { const float e = (float)(2 * i) / 64.0f; const float p = powf(10000.0f, e); a.inv_m[i] = 1.0f / p; }
    for (int i = 0; i < 8; ++i) { const float e = (float)(2 * i) / 16.0f; const float p = powf(500000.0f, e); a.inv_d[i] = 1.0f / p; }
    for (int i = 0; i < 4; ++i) a.lam_init[i] = (float)(0.8 - 0.6 * exp(-0.3 * (double)i));
#if MK_SPLIT
    for (int p = 0; p < 44; ++p) { a.ph_lo = p; a.ph_hi = p + 1; hipLaunchKernelGGL(enc_fwd, dim3(grid), dim3(NWAVES * 64), LDS_BYTES, stream, a); }
#else
    a.ph_lo = 0; a.ph_hi = 44;
    hipLaunchKernelGGL(enc_fwd, dim3(grid), dim3(NWAVES * 64), LDS_BYTES, stream, a);
#endif
    const hipError_t le = hipPeekAtLastError();
    if (le != hipSuccess) fprintf(stderr, "kernel_launch: launch failed: %s\n", hipGetErrorName(le));
}
```

```cpp
#include <hip/hip_runtime.h>
#include <cstdio>
#include <cstdint>
#include <cmath>
#include <utility>
#include <type_traits>

#ifndef PH_MASK
#define PH_MASK 0x3fff
#endif
#define PH_ON(k) (((PH_MASK) >> (k)) & 1)
#ifndef PROBE_MASK
#define PROBE_MASK 0
#endif
#define NREP(k) ((((PROBE_MASK) >> (k)) & 1) ? 2 : 1)
#ifndef MLA_PIPE
#define MLA_PIPE true
#endif
#ifndef CVT_AHEAD
#define CVT_AHEAD 1
#endif
#ifndef MK_SPLIT
#define MK_SPLIT 0
#endif

constexpr int DM = 2048, MROWS = 24576, NLAYER = 4, SEQ_P = 16384, SEQ_S = 4096;
constexpr int NPROJ = 5056, NPROJ_P = 5120, DFF = 5632, PLE = 256;
constexpr int C_NAQ = 0, C_NAK = 768, C_NAV = 1536, C_CQ = 2304, C_CKV = 2816, C_KPE = 3072, C_DFQ = 3136, C_DFK = 3776, C_DFV = 4416;
constexpr int LD_QM = 1024, LD_KVM = 1280, LD_KF = 960, LD_GU = 2 * DFF;
constexpr float EPS = 1e-6f;

typedef unsigned short bf16_t;
typedef short bf16x8 __attribute__((ext_vector_type(8)));
typedef short s16x4 __attribute__((ext_vector_type(4)));
typedef float f32x4 __attribute__((ext_vector_type(4)));
typedef float f32x2 __attribute__((ext_vector_type(2)));
typedef float f32x16 __attribute__((ext_vector_type(16)));
typedef unsigned u32x4 __attribute__((ext_vector_type(4)));
typedef unsigned u32x2 __attribute__((ext_vector_type(2)));

#define GAS __attribute__((address_space(1)))
#define LAS __attribute__((address_space(3)))

typedef __bf16 bf16x2_t __attribute__((ext_vector_type(2)));
__device__ __forceinline__ unsigned cvt_pk_bf16(float lo, float hi) { f32x2 v = {lo, hi}; bf16x2_t b = __builtin_convertvector(v, bf16x2_t); return __builtin_bit_cast(unsigned, b); }
__device__ __forceinline__ float bf_lo(unsigned w) { return __uint_as_float(w << 16); }
__device__ __forceinline__ float bf_hi(unsigned w) { return __uint_as_float(w & 0xffff0000u); }
__device__ __forceinline__ float bf2f(bf16_t h) { return __uint_as_float((unsigned)h << 16); }
__device__ __forceinline__ bf16_t f2bf(float f) { return (bf16_t)(cvt_pk_bf16(f, 0.f) & 0xffffu); }
__device__ __forceinline__ float sigm(float x) { return __builtin_amdgcn_rcpf(1.f + __builtin_amdgcn_exp2f(x * -1.4426950408889634f)); }
template <int X> __device__ __forceinline__ float swz_xor(float v) { return __int_as_float(__builtin_amdgcn_ds_swizzle(__float_as_int(v), (X << 10) | 0x1f)); }
__device__ __forceinline__ float xor32_sum(float v) { auto rr = __builtin_amdgcn_permlane32_swap(__float_as_uint(v), __float_as_uint(v), false, false); return __uint_as_float(rr[0]) + __uint_as_float(rr[1]); }
template <int CTRL> __device__ __forceinline__ float dpp_mov(float v) { return __int_as_float(__builtin_amdgcn_update_dpp(0, __float_as_int(v), CTRL, 0xf, 0xf, true)); }
__device__ __forceinline__ float xor16_sum(float v) { auto rr = __builtin_amdgcn_permlane16_swap(__float_as_uint(v), __float_as_uint(v), false, false); return __uint_as_float(rr[0]) + __uint_as_float(rr[1]); }
__device__ __forceinline__ float wsum32(float v) { v += dpp_mov<0xB1>(v); v += dpp_mov<0x4E>(v); v += dpp_mov<0x141>(v); v += dpp_mov<0x140>(v); return xor16_sum(v); }
__device__ __forceinline__ float wsum64(float v) { return xor32_sum(wsum32(v)); }
__device__ __forceinline__ int lane_id() { int l; asm volatile("v_mbcnt_lo_u32_b32 %0, -1, 0\n\tv_mbcnt_hi_u32_b32 %0, -1, %0" : "=v"(l)); return l; }
namespace pg8 {
constexpr int BM = 256, BK = 64, HALF = 128, HTB = HALF * BK * 2, STAGE_BYTES = 8 * HTB, NXCD = 8, WGM = 4;
__host__ __device__ __forceinline__ int lds_byte(int r, int c) { const int st = (r >> 4) * 2 + (c >> 5), rr = r & 15, cc = c & 31, ob = rr * 64 + cc * 2; return st * 1024 + (ob ^ (((ob >> 9) & 1) << 5)); }
__host__ __device__ __forceinline__ void stage_rc(int b, int& R, int& C) { const int st = b / 1024, sb = b % 1024, swz = sb ^ (((sb >> 9) & 1) << 5); R = (st >> 1) * 16 + swz / 64; C = (st & 1) * 32 + (swz % 64) / 2; }
__host__ __device__ __forceinline__ int perm32(int rho) { const int n = rho >> 4, i = rho & 15; return 8 * (i >> 2) + 4 * n + (i & 3); }

struct Unit { int pm, pn; };
struct Gemm { const bf16_t* A; const bf16_t* Bt; int M, N, K, lda; };

struct StaticOrder {
    int nM, nN, nwg, G, c;
    __device__ void init(int M, int N, int G_, int c_) { nM = M / BM; nN = N / BM; nwg = nM * nN; G = G_; c = c_; }
    __device__ bool next(int i, Unit& u) const {
        const long L = (long)i * G + c; if (L >= nwg) return false;
        int wgid = (int)L; { const int q = nwg / NXCD, r = nwg % NXCD, xcd = wgid % NXCD, off = wgid / NXCD; wgid = (xcd < r ? xcd * (q + 1) : r * (q + 1) + (xcd - r) * q) + off; }
        const int nig = WGM * nN, gid = wgid / nig, fm = gid * WGM, gsz = (nM - fm) < WGM ? (nM - fm) : WGM;
        u.pm = fm + ((wgid % nig) % gsz); u.pn = (wgid % nig) / gsz; return true;
    }
};

template <class Epi>
__device__ __forceinline__ void gemm_phase(LAS unsigned char* lds, const Gemm g, const StaticOrder& S, const Epi& E, int wave) {
    int lane_ = lane_id(); asm volatile("" : "+v"(lane_));
    const int wid = wave, lane = lane_, tid = wid * 64 + lane, wr = wid >> 2, wc = wid & 3, fr = lane & 15, fq = lane >> 4;
    const int K = g.K, nt = K / BK, lda = g.lda;
    unsigned voffA[2], voffB[2];
#pragma unroll
    for (int i = 0; i < 2; ++i) { int R, C; stage_rc(tid * 16 + i * 8192, R, C); const int Rb = (R & ~31) + perm32(R & 31);
        voffA[i] = (unsigned)(R * lda + C) * 2u; voffB[i] = (unsigned)(Rb * K + C) * 2u; }
    const size_t kstep = (size_t)(BK * 2);
    const size_t hstepA = (size_t)HALF * lda * 2, hstepB = (size_t)HALF * K * 2;
    const size_t tstepA = 2 * hstepA, tstepB = 2 * hstepB;
    const unsigned ldsw = (unsigned)wid * 1024u;
    const int aoff = lds_byte(wr * 64 + fr, fq * 8), boff = lds_byte(wc * 32 + fr, fq * 8);
#define PG8_SA(b, h) (((b) * 2 + (h)) * HTB)
#define PG8_SB(b, h) ((4 + (b) * 2 + (h)) * HTB)
#define PG8_STAGE(bufoff, gbase, voff) do { _Pragma("unroll") for (int _i = 0; _i < 2; ++_i) \
        __builtin_amdgcn_global_load_lds((const unsigned*)((const char*)(gbase) + (voff)[_i]), (LAS unsigned*)(lds + (bufoff) + ldsw + _i * 8192), 16, 0, 0); } while (0)
#define PG8_LDA(dst, b, h) do { _Pragma("unroll") for (int m = 0; m < 4; ++m) _Pragma("unroll") for (int k = 0; k < 2; ++k) dst[m][k] = *(const LAS bf16x8*)(lds + PG8_SA(b, h) + aoff + m * 2048 + k * 1024); } while (0)
#define PG8_LDB(dst, b, h) do { _Pragma("unroll") for (int n = 0; n < 2; ++n) _Pragma("unroll") for (int k = 0; k < 2; ++k) dst[n][k] = *(const LAS bf16x8*)(lds + PG8_SB(b, h) + boff + n * 2048 + k * 1024); } while (0)
#define PG8_MMA(ai, bj, At, Bt) do { __builtin_amdgcn_s_setprio(1); _Pragma("unroll") for (int m = 0; m < 4; ++m) _Pragma("unroll") for (int n = 0; n < 2; ++n) _Pragma("unroll") for (int k = 0; k < 2; ++k) \
        acc[ai][bj][m][n] = __builtin_amdgcn_mfma_f32_16x16x32_bf16(Bt[n][k], At[m][k], acc[ai][bj][m][n], 0, 0, 0); __builtin_amdgcn_s_setprio(0); } while (0)
#define PG8_WAIT_V(n) asm volatile("s_waitcnt vmcnt(" #n ")" ::: "memory")
#define PG8_WAIT_L(n) asm volatile("s_waitcnt lgkmcnt(" #n ")" ::: "memory")
#define PG8_BAR __builtin_amdgcn_s_barrier()
#define PG8_SCHED __builtin_amdgcn_sched_barrier(0)
    Unit cur, nxt; int ui = 0;
    if (!S.next(0, cur)) return;
    f32x4 acc[2][2][4][2];
#pragma unroll
    for (int a = 0; a < 2; ++a)
#pragma unroll
        for (int b = 0; b < 2; ++b)
#pragma unroll
            for (int m = 0; m < 4; ++m)
#pragma unroll
                for (int n = 0; n < 2; ++n) acc[a][b][m][n] = (f32x4){0.f, 0.f, 0.f, 0.f};
    bf16x8 At[4][2], B0[2][2], B1[2][2];
    const char* cA = (const char*)g.A + (size_t)cur.pm * tstepA; const char* cB = (const char*)g.Bt + (size_t)cur.pn * tstepB;
    PG8_STAGE(PG8_SB(0, 0), cB, voffB); PG8_STAGE(PG8_SB(0, 1), cB + hstepB, voffB); PG8_STAGE(PG8_SA(0, 0), cA, voffA); PG8_STAGE(PG8_SA(0, 1), cA + hstepA, voffA);
    if (wr == 1) PG8_BAR;
    PG8_WAIT_V(2); PG8_BAR;
    PG8_STAGE(PG8_SB(1, 0), cB + kstep, voffB); PG8_STAGE(PG8_SA(1, 0), cA + kstep, voffA); PG8_STAGE(PG8_SB(1, 1), cB + hstepB + kstep, voffB);
    PG8_WAIT_V(6); PG8_BAR;
    for (;;) {
        const bool has_next = S.next(ui + 1, nxt);
        const char* nA = has_next ? (const char*)g.A + (size_t)nxt.pm * tstepA : cA; const char* nB = has_next ? (const char*)g.Bt + (size_t)nxt.pn * tstepB : cB;
        for (int t = 0; t < nt; t += 2) {
            const bool last = (t == nt - 2);
            const char* a1 = cA + (size_t)(t + 1) * kstep;
            const char* a2 = last ? nA : cA + (size_t)(t + 2) * kstep; const char* b2 = last ? nB : cB + (size_t)(t + 2) * kstep;
            const char* a3 = a2 + kstep; const char* b3 = b2 + kstep;
            PG8_LDB(B0, 0, 0); PG8_LDB(B1, 0, 1); PG8_SCHED; PG8_LDA(At, 0, 0); PG8_STAGE(PG8_SA(1, 1), a1 + hstepA, voffA);
            PG8_WAIT_V(8); PG8_WAIT_L(0); PG8_BAR; PG8_MMA(0, 0, At, B0); PG8_MMA(0, 1, At, B1); PG8_BAR; PG8_SCHED;
            PG8_LDA(At, 0, 1); PG8_STAGE(PG8_SB(0, 0), b2, voffB); PG8_STAGE(PG8_SB(0, 1), b2 + hstepB, voffB); PG8_STAGE(PG8_SA(0, 0), a2, voffA);
            PG8_WAIT_V(8); PG8_WAIT_L(0); PG8_BAR; PG8_MMA(1, 0, At, B0); PG8_MMA(1, 1, At, B1); PG8_BAR; PG8_SCHED;
            PG8_LDB(B0, 1, 0); PG8_LDB(B1, 1, 1); PG8_SCHED; PG8_LDA(At, 1, 0); PG8_STAGE(PG8_SA(0, 1), a2 + hstepA, voffA);
            PG8_WAIT_V(8); PG8_WAIT_L(0); PG8_BAR; PG8_MMA(0, 0, At, B0); PG8_MMA(0, 1, At, B1); PG8_BAR; PG8_SCHED;
            PG8_LDA(At, 1, 1); PG8_STAGE(PG8_SB(1, 0), b3, voffB); PG8_STAGE(PG8_SB(1, 1), b3 + hstepB, voffB); PG8_STAGE(PG8_SA(1, 0), a3, voffA);
            PG8_WAIT_V(8); PG8_WAIT_L(0); PG8_BAR; PG8_MMA(1, 0, At, B0); PG8_MMA(1, 1, At, B1); PG8_BAR; PG8_SCHED;
        }
        if (wr == 0) PG8_BAR;
        E(acc, cur, wr, wc, fr, fq);
        if (!has_next) break;
#pragma unroll
        for (int a = 0; a < 2; ++a)
#pragma unroll
            for (int b = 0; b < 2; ++b)
#pragma unroll
                for (int m = 0; m < 4; ++m)
#pragma unroll
                    for (int n = 0; n < 2; ++n) acc[a][b][m][n] = (f32x4){0.f, 0.f, 0.f, 0.f};
        cur = nxt; cA = nA; cB = nB; ++ui;
        if (wr == 1) PG8_BAR;
    }
    PG8_WAIT_V(0);
    PG8_BAR;
#undef PG8_SA
#undef PG8_SB
#undef PG8_STAGE
#undef PG8_LDA
#undef PG8_LDB
#undef PG8_MMA
#undef PG8_WAIT_V
#undef PG8_WAIT_L
#undef PG8_BAR
#undef PG8_SCHED
}

__device__ __forceinline__ void load_rstd(const float* ss, int row_base, int fq, float (&rs)[2][4]) {
#pragma unroll
    for (int ai = 0; ai < 2; ++ai)
#pragma unroll
        for (int m = 0; m < 4; ++m) {
            const f32x4* p = (const f32x4*)(ss + (size_t)(row_base + ai * HALF + m * 16) * 32 + fq * 8);
            const f32x4 a = p[0], b = p[1];
            float s = ((a[0] + a[1]) + (a[2] + a[3])) + ((b[0] + b[1]) + (b[2] + b[3]));
            s = xor32_sum(xor16_sum(s));
            rs[ai][m] = rsqrtf(s * (1.0f / DM) + EPS);
        }
}
template <bool RS> struct EpiScaleBf16 {
    bf16_t* O; int ldc; const float* ss; float* ssq;
    __device__ __forceinline__ void operator()(const f32x4 (&acc)[2][2][4][2], const Unit& u, int wr, int wc, int fr, int fq) const {
        const int row0 = u.pm * BM + wr * 64 + fr, col0 = u.pn * BM + wc * 32 + 8 * fq;
        float rs[2][4];
        if (RS) load_rstd(ss, row0, fq, rs);
        const bool wsq = ssq != nullptr && u.pn >= 9 && u.pn < 12;
#pragma unroll
        for (int ai = 0; ai < 2; ++ai)
#pragma unroll
            for (int m = 0; m < 4; ++m) { bf16_t* rowp = O + (size_t)(row0 + ai * HALF + m * 16) * ldc + col0; const float sc = RS ? rs[ai][m] : 1.f;
                float sq = 0.f;
#pragma unroll
                for (int bj = 0; bj < 2; ++bj) { const f32x4 v0 = acc[ai][bj][m][0] * sc, v1 = acc[ai][bj][m][1] * sc;
                    u32x4 w; w.x = cvt_pk_bf16(v0[0], v0[1]); w.y = cvt_pk_bf16(v0[2], v0[3]); w.z = cvt_pk_bf16(v1[0], v1[1]); w.w = cvt_pk_bf16(v1[2], v1[3]);
                    *(u32x4*)(rowp + bj * HALF) = w;
                    if (wsq) sq += (v0[0] * v0[0] + v0[1] * v0[1]) + (v0[2] * v0[2] + v0[3] * v0[3]) + (v1[0] * v1[0] + v1[1] * v1[1]) + (v1[2] * v1[2] + v1[3] * v1[3]); }
                if (wsq) { sq = xor32_sum(xor16_sum(sq)); if (fq == 0) ssq[(size_t)(row0 + ai * HALF + m * 16) * 16 + (u.pn - 9) * 4 + wc] = sq; } }
    }
};
template <int NP, int DIVN> struct EpiScaleLat {
    bf16_t* O; int ldc; const float* ssq;
    __device__ __forceinline__ void operator()(const f32x4 (&acc)[2][2][4][2], const Unit& u, int wr, int wc, int fr, int fq) const {
        const int l_ = lane_id(), fql = l_ >> 4;
        const int row0 = u.pm * BM + wr * 64 + (l_ & 15), col0 = u.pn * BM + wc * 32 + 8 * fql; (void)fr; (void)fq;
        float rs[2][4];
#pragma unroll
        for (int ai = 0; ai < 2; ++ai)
#pragma unroll
            for (int m = 0; m < 4; ++m) {
                const float* p = ssq + (size_t)(row0 + ai * HALF + m * 16) * 16 + fql * (NP / 4);
                float sq = p[0]; if (NP == 8) sq += p[1];
                sq = xor32_sum(xor16_sum(sq));
                rs[ai][m] = rsqrtf(sq * (1.0f / DIVN) + EPS);
            }
#pragma unroll
        for (int ai = 0; ai < 2; ++ai)
#pragma unroll
            for (int m = 0; m < 4; ++m) { bf16_t* rowp = O + (size_t)(row0 + ai * HALF + m * 16) * ldc + col0; const float sc = rs[ai][m];
#pragma unroll
                for (int bj = 0; bj < 2; ++bj) { const f32x4 v0 = acc[ai][bj][m][0] * sc, v1 = acc[ai][bj][m][1] * sc;
                    u32x4 w; w.x = cvt_pk_bf16(v0[0], v0[1]); w.y = cvt_pk_bf16(v0[2], v0[3]); w.z = cvt_pk_bf16(v1[0], v1[1]); w.w = cvt_pk_bf16(v1[2], v1[3]);
                    *(u32x4*)(rowp + bj * HALF) = w; } }
    }
};
struct EpiKvm {
    bf16_t* kvm; bf16_t* kf; const float* ssq; const float* g_kn; LAS float* xl;
    __device__ __forceinline__ void operator()(const f32x4 (&acc)[2][2][4][2], const Unit& u, int wr, int wc, int fr, int fq) const {
        const int l_ = lane_id(), fql = l_ >> 4, rowl = wr * 64 + (l_ & 15), colh = wc * 32 + 8 * fql; (void)fr; (void)fq;
        const int row0 = u.pm * BM + rowl;
        float rs[2][4];
#pragma unroll
        for (int ai = 0; ai < 2; ++ai)
#pragma unroll
            for (int m = 0; m < 4; ++m) {
                const float* p = ssq + (size_t)(row0 + ai * HALF + m * 16) * 16 + fql;
                float sq = p[0]; sq = xor32_sum(xor16_sum(sq));
                rs[ai][m] = rsqrtf(sq * (1.0f / 256.0f) + EPS);
            }
#pragma unroll
        for (int ai = 0; ai < 2; ++ai)
#pragma unroll
            for (int m = 0; m < 4; ++m) { const float sc = rs[ai][m];
                { const f32x4 v0 = acc[ai][1][m][0] * sc, v1 = acc[ai][1][m][1] * sc;
                  u32x4 w; w.x = cvt_pk_bf16(v0[0], v0[1]); w.y = cvt_pk_bf16(v0[2], v0[3]); w.z = cvt_pk_bf16(v1[0], v1[1]); w.w = cvt_pk_bf16(v1[2], v1[3]);
                  *(u32x4*)(kvm + (size_t)(row0 + ai * HALF + m * 16) * LD_KVM + u.pn * 256 + 128 + colh) = w; }
                const f32x4 k0 = acc[ai][0][m][0] * sc, k1 = acc[ai][0][m][1] * sc;
                float sq = (k0[0] * k0[0] + k0[1] * k0[1]) + (k0[2] * k0[2] + k0[3] * k0[3]) + (k1[0] * k1[0] + k1[1] * k1[1]) + (k1[2] * k1[2] + k1[3] * k1[3]);
                sq = xor32_sum(xor16_sum(sq));
                if (fql == 0) xl[(rowl + ai * HALF + m * 16) * 4 + wc] = sq; }
        asm volatile("s_waitcnt lgkmcnt(0)" ::: "memory"); __builtin_amdgcn_s_barrier(); asm volatile("" ::: "memory");
        const f32x4 g0 = *(const f32x4*)(g_kn + colh), g1 = *(const f32x4*)(g_kn + colh + 4);
#pragma unroll
        for (int ai = 0; ai < 2; ++ai)
#pragma unroll
            for (int m = 0; m < 4; ++m) { const f32x4 pp = *(const LAS f32x4*)(xl + (rowl + ai * HALF + m * 16) * 4);
                const float sc = rs[ai][m], rh = rsqrtf(((pp[0] + pp[1]) + (pp[2] + pp[3])) * (1.0f / 128.0f) + EPS);
                const f32x4 k0 = acc[ai][0][m][0] * sc * rh * g0, k1 = acc[ai][0][m][1] * sc * rh * g1;
                u32x4 w; w.x = cvt_pk_bf16(k0[0], k0[1]); w.y = cvt_pk_bf16(k0[2], k0[3]); w.z = cvt_pk_bf16(k1[0], k1[1]); w.w = cvt_pk_bf16(k1[2], k1[3]);
                *(u32x4*)(kf + (size_t)(row0 + ai * HALF + m * 16) * LD_KF + u.pn * 192 + colh) = w; }
    }
};
template <bool GATE> struct EpiResidual {
    const bf16_t* xin; float* xout; bf16_t* xbf; float* ss_out; const float* ss_in; const bf16_t* pp;
    __device__ __forceinline__ void operator()(const f32x4 (&acc)[2][2][4][2], const Unit& u, int wr, int wc, int fr, int fq) const {
        const int row0 = u.pm * BM + wr * 64 + fr, col0 = u.pn * BM + wc * 32 + 8 * fq;
        float rs[2][4];
        if (GATE) load_rstd(ss_in, row0, fq, rs);
#pragma unroll
        for (int ai = 0; ai < 2; ++ai)
#pragma unroll
            for (int m = 0; m < 4; ++m) {
                const int row = row0 + ai * HALF + m * 16;
                const size_t off = (size_t)row * DM + col0;
                float sq = 0.f;
#pragma unroll
                for (int bj = 0; bj < 2; ++bj) {
                    f32x4 d0 = acc[ai][bj][m][0], d1 = acc[ai][bj][m][1];
                    if (GATE) {
                        const u32x4 pw = *(const u32x4*)(pp + off + bj * HALF);
                        const float sc = rs[ai][m];
                        f32x4 p0 = {bf_lo(pw.x), bf_hi(pw.x), bf_lo(pw.y), bf_hi(pw.y)}, p1 = {bf_lo(pw.z), bf_hi(pw.z), bf_lo(pw.w), bf_hi(pw.w)};
#pragma unroll
                        for (int e = 0; e < 4; ++e) { d0[e] = p0[e] * sigm(d0[e] * sc); d1[e] = p1[e] * sigm(d1[e] * sc); }
                    }
                    const u32x4 xw = *(const u32x4*)(xin + off + bj * HALF);
                    const f32x4 x0 = {bf_lo(xw.x), bf_hi(xw.x), bf_lo(xw.y), bf_hi(xw.y)}, x1 = {bf_lo(xw.z), bf_hi(xw.z), bf_lo(xw.w), bf_hi(xw.w)};
                    const f32x4 o0 = x0 + d0, o1 = x1 + d1;
                    if (xout) { *(f32x4*)(xout + off + bj * HALF) = o0; *(f32x4*)(xout + off + bj * HALF + 4) = o1; }
                    u32x4 w; w.x = cvt_pk_bf16(o0[0], o0[1]); w.y = cvt_pk_bf16(o0[2], o0[3]); w.z = cvt_pk_bf16(o1[0], o1[1]); w.w = cvt_pk_bf16(o1[2], o1[3]);
                    *(u32x4*)(xbf + off + bj * HALF) = w;
                    sq += (o0[0] * o0[0] + o0[1] * o0[1]) + (o0[2] * o0[2] + o0[3] * o0[3]) + (o1[0] * o1[0] + o1[1] * o1[1]) + (o1[2] * o1[2] + o1[3] * o1[3]);
                }
                sq = xor32_sum(xor16_sum(sq));
                if (fq == 0) ss_out[(size_t)row * 32 + u.pn * 4 + wc] = sq;
            }
    }
};
struct EpiGateUp {
    bf16_t* act; const float* ss; const float* cw; const float* cb; LAS unsigned* xlds; float* edge;
    __device__ __forceinline__ void operator()(const f32x4 (&acc)[2][2][4][2], const Unit& u, int wr, int wc, int fr_, int fq_) const {
        int fr = fr_, fq = fq_; asm volatile("" : "+v"(fr), "+v"(fq));
        const int rl0 = wr * 64 + fr, cl = wc * 32 + 8 * fq, colF = u.pn * 128 + cl;
        float rs[2][4];
        load_rstd(ss, u.pm * BM + rl0, fq, rs);
        const int lane = fq * 16 + fr;
        const int iup = ((lane & 0x30) | ((lane - 1) & 15)) << 2, idn = ((lane & 0x30) | ((lane + 1) & 15)) << 2;
        { const int t = (wr * 4 + wc) * 64 + lane, arr = t >> 7, c = t & 127;
          ((LAS float*)xlds)[512 + t] = (arr < 3) ? cw[(size_t)arr * DFF + u.pn * 128 + c] : cb[u.pn * 128 + c]; }
#define LAUNDER(p) asm volatile("" : "+v"(p))
        GAS bf16_t* pa = (GAS bf16_t*)(act + (size_t)(u.pm * BM + rl0) * DFF + colF);
        unsigned gp[2][4][4];
#pragma unroll
        for (int ai = 0; ai < 2; ++ai)
#pragma unroll
            for (int m = 0; m < 4; ++m) { const f32x4 v0 = acc[ai][0][m][0] * rs[ai][m], v1 = acc[ai][0][m][1] * rs[ai][m];
                gp[ai][m][0] = cvt_pk_bf16(v0[0], v0[1]); gp[ai][m][1] = cvt_pk_bf16(v0[2], v0[3]); gp[ai][m][2] = cvt_pk_bf16(v1[0], v1[1]); gp[ai][m][3] = cvt_pk_bf16(v1[2], v1[3]); }
        if (fr == 0)  { *(LAS u32x4*)(xlds + ((0 * 2 + wr) * 2 + 0) * 64 + (cl >> 1)) = (u32x4){gp[0][0][0], gp[0][0][1], gp[0][0][2], gp[0][0][3]};
                        *(LAS u32x4*)(xlds + ((1 * 2 + wr) * 2 + 0) * 64 + (cl >> 1)) = (u32x4){gp[1][0][0], gp[1][0][1], gp[1][0][2], gp[1][0][3]}; }
        if (fr == 15) { *(LAS u32x4*)(xlds + ((0 * 2 + wr) * 2 + 1) * 64 + (cl >> 1)) = (u32x4){gp[0][3][0], gp[0][3][1], gp[0][3][2], gp[0][3][3]};
                        *(LAS u32x4*)(xlds + ((1 * 2 + wr) * 2 + 1) * 64 + (cl >> 1)) = (u32x4){gp[1][3][0], gp[1][3][1], gp[1][3][2], gp[1][3][3]}; }
        asm volatile("s_waitcnt lgkmcnt(0)" ::: "memory"); __builtin_amdgcn_s_barrier(); asm volatile("" ::: "memory");
#pragma unroll
        for (int ai = 0; ai < 2; ++ai) {
            const bool has_top = (wr == 1) || (ai == 1), has_bot = (wr == 0) || (ai == 0);
            const int tsel = (wr == 1) ? ((ai * 2 + 0) * 2 + 1) : ((0 * 2 + 1) * 2 + 1), bsel = (wr == 0) ? ((ai * 2 + 1) * 2 + 0) : ((1 * 2 + 0) * 2 + 0);
            const u32x4 z4 = {0u, 0u, 0u, 0u};
            const u32x4 topv = has_top ? *(const LAS u32x4*)(xlds + tsel * 64 + (cl >> 1)) : z4, botv = has_bot ? *(const LAS u32x4*)(xlds + bsel * 64 + (cl >> 1)) : z4;
            unsigned ur[4][4], dl[4][4];
#pragma unroll
            for (int m = 0; m < 4; ++m)
#pragma unroll
                for (int j = 0; j < 4; ++j) { ur[m][j] = (unsigned)__builtin_amdgcn_ds_bpermute(iup, (int)gp[ai][m][j]); dl[m][j] = (unsigned)__builtin_amdgcn_ds_bpermute(idn, (int)gp[ai][m][j]); }
            const bool e_first = (ai == 0 && wr == 0 && fr == 0), e_last = (ai == 1 && wr == 1 && fr == 15);
            float* const ep = edge + (size_t)(ai == 0 ? 0 : 3) * (96 * DFF) + (size_t)u.pm * DFF + colF;
#pragma unroll
            for (int m = 0; m < 4; ++m) {
                unsigned opk[4];
#pragma unroll
                for (int j = 0; j < 4; ++j) {
                    const unsigned upw = (fr > 0) ? ur[m][j] : (m > 0 ? ur[m > 0 ? m - 1 : 0][j] : topv[j]);
                    const unsigned dnw = (fr < 15) ? dl[m][j] : (m < 3 ? dl[m < 3 ? m + 1 : 3][j] : botv[j]);
                    const LAS f32x2* wl = (const LAS f32x2*)((const LAS float*)xlds + 512 + cl + 2 * j);
                    const f32x2 w0 = wl[0], w1 = wl[64], w2 = wl[128], bb = wl[192];
                    const float g0 = acc[ai][0][m][j >> 1][2 * (j & 1)] * rs[ai][m], g1 = acc[ai][0][m][j >> 1][2 * (j & 1) + 1] * rs[ai][m];
                    const float u0 = acc[ai][1][m][j >> 1][2 * (j & 1)] * rs[ai][m], u1 = acc[ai][1][m][j >> 1][2 * (j & 1) + 1] * rs[ai][m];
                    const float p0 = w1[0] * g0 + bb[0] + w0[0] * bf_lo(upw) + w2[0] * bf_lo(dnw), p1 = w1[1] * g1 + bb[1] + w0[1] * bf_hi(upw) + w2[1] * bf_hi(dnw);
                    opk[j] = cvt_pk_bf16(p0 * sigm(p0) * u0, p1 * sigm(p1) * u1);
                    if ((m == 0 && e_first) || (m == 3 && e_last)) { ep[2 * j] = p0; ep[2 * j + 1] = p1; ep[96 * DFF + 2 * j] = g0; ep[96 * DFF + 2 * j + 1] = g1; ep[2 * 96 * DFF + 2 * j] = u0; ep[2 * 96 * DFF + 2 * j + 1] = u1; }
                }
                if (!((m == 0 && e_first) || (m == 3 && e_last))) { u32x4 w; w.x = opk[0]; w.y = opk[1]; w.z = opk[2]; w.w = opk[3]; *(GAS u32x4*)pa = w; }
                pa += (size_t)(m == 3 ? 80 : 16) * DFF; LAUNDER(pa);
                __builtin_amdgcn_sched_barrier(0);
            }
        }
#undef LAUNDER
    }
};
}

namespace att {
constexpr int NW = 8, QBLK = 32, KVBLK = 64;
constexpr int SHM_V = 16384, OFF_V = 0, OFF_K = 49152, OFF_WS = 122880, ATT_LDS = 124928;
#define SBAR() __builtin_amdgcn_sched_barrier(0)
__device__ __forceinline__ int crow(int r, int hi) { return (r & 3) + 8 * (r >> 2) + 4 * hi; }
__device__ __forceinline__ void finishSM(f32x16& p0, f32x16& p1, float& l_reg, bf16x8& pa0, bf16x8& pa1, bf16x8& pa2, bf16x8& pa3) {
#pragma unroll
    for (int r = 0; r < 16; ++r) p0[r] = __builtin_amdgcn_exp2f(p0[r]);
#pragma unroll
    for (int r = 0; r < 16; ++r) p1[r] = __builtin_amdgcn_exp2f(p1[r]);
    float ps = 0;
#pragma unroll
    for (int r = 0; r < 16; ++r) ps += p0[r];
#pragma unroll
    for (int r = 0; r < 16; ++r) ps += p1[r];
    l_reg += ps;
#define PK4(P, BASE, OUT) do { unsigned a0 = cvt_pk_bf16(P[BASE + 0], P[BASE + 1]), a1 = cvt_pk_bf16(P[BASE + 2], P[BASE + 3]);   \
    unsigned b0 = cvt_pk_bf16(P[BASE + 4], P[BASE + 5]), b1 = cvt_pk_bf16(P[BASE + 6], P[BASE + 7]);                              \
    u32x4 w = {a0, a1, b0, b1}; OUT = *reinterpret_cast<bf16x8*>(&w); } while (0)
    PK4(p0, 0, pa0); PK4(p0, 8, pa1); PK4(p1, 0, pa2); PK4(p1, 8, pa3);
#undef PK4
}
template <int NQK> struct KB { static constexpr int NB = (NQK == 12) ? 4 : NQK; unsigned a[NB]; };
template <int NQK> __device__ __forceinline__ void kb_init(KB<NQK>& kb, unsigned k_lds_addr, int r32, int hi) {
    constexpr int NB = KB<NQK>::NB; const int f = (NQK == 8) ? (r32 & 15) : ((r32 >> 1) & 7);
#pragma unroll
    for (int k = 0; k < NB; ++k) kb.a[k] = k_lds_addr + (unsigned)(r32 * (NQK * 32) + (((2 * k + hi) ^ f) << 4));
}
__device__ __forceinline__ int v_rd_base(int lane) { return ((lane & 3) << 3) | (((lane >> 2) & 3) << 6) | (((lane >> 4) & 1) << 5) | (((lane >> 5) & 1) << 8); }
constexpr int v_rd_off(int d0, int ks, int half) { return d0 * 512 + ks * 4096 + half * 2048; }
struct NoHook { __device__ __forceinline__ void operator()(f32x16&, f32x16&, int, int) const {} };
struct NaHook {
    const LAS float* bias;
    int kr_lo, rq, rs, c, cs;
    __device__ __forceinline__ void operator()(f32x16& p0, f32x16& p1, int j, int hi) const {
        int t_ = 4 * hi - cs; asm volatile("" : "+v"(t_));
        float ninf; asm volatile("v_mov_b32 %0, 0xff800000" : "=v"(ninf));
        const int kr = kr_lo + j; const bool rowok = (kr >= rs) && (kr < rs + 8);
        const LAS float* bp = bias + ((kr - rq + 7) * 31 - c + 15 + 4 * hi);
#pragma unroll
        for (int r = 0; r < 16; ++r) {
            const int cj = (r & 3) + 8 * (r >> 2);
            const bool ok0 = rowok && ((unsigned)(t_ + cj) < 16u), ok1 = rowok && ((unsigned)(t_ + cj + 32) < 16u);
            const float b0 = bp[cj], b1 = bp[cj + 32];
            p0[r] = ok0 ? fmaf(b0, 1.4426950408889634f, p0[r]) : ninf;
            p1[r] = ok1 ? fmaf(b1, 1.4426950408889634f, p1[r]) : ninf;
        }
    }
};
__device__ __forceinline__ void q_unpack(const bf16x8& q, float (&v)[8]) { const u32x4 w = __builtin_bit_cast(u32x4, q);
    v[0] = bf_lo(w.x); v[1] = bf_hi(w.x); v[2] = bf_lo(w.y); v[3] = bf_hi(w.y); v[4] = bf_lo(w.z); v[5] = bf_hi(w.z); v[6] = bf_lo(w.w); v[7] = bf_hi(w.w); }
__device__ __forceinline__ bf16x8 q_pack(const float (&v)[8]) { const u32x4 w = {cvt_pk_bf16(v[0], v[1]), cvt_pk_bf16(v[2], v[3]), cvt_pk_bf16(v[4], v[5]), cvt_pk_bf16(v[6], v[7])}; return __builtin_bit_cast(bf16x8, w); }
template <int A, int B> __device__ __forceinline__ float q_rstd(const bf16x8* qr) {
    float ss = 0.f;
#pragma unroll
    for (int d0 = A; d0 < B; ++d0) { float v[8]; q_unpack(qr[d0], v);
#pragma unroll
        for (int e = 0; e < 8; ++e) ss = fmaf(v[e], v[e], ss); }
    return rsqrtf(xor32_sum(ss) * (1.0f / (16 * (B - A))) + EPS);
}
__device__ __forceinline__ void q_scale(float (&v)[8], float r, const float* g8, float scale) { const f32x4 g0 = *(const f32x4*)g8 * scale, g1 = *(const f32x4*)(g8 + 4) * scale;
#pragma unroll
    for (int e = 0; e < 4; ++e) { v[e] = v[e] * r * g0[e]; v[e + 4] = v[e + 4] * r * g1[e]; } }
#define QL(x) asm volatile("" : "+v"(x))
#define QDEP(dep, q) do { const unsigned w_ = __builtin_bit_cast(u32x4, q).x; asm volatile("" : "+v"(dep) : "v"(w_)); } while (0)
struct QNone { __device__ __forceinline__ void operator()(bf16x8*, int, int) const {} };
struct QNormNA {
    const float* g; float scale;
    __device__ __forceinline__ void operator()(bf16x8* qr, int, int hi) const {
        const float r = q_rstd<0, 8>(qr); int dep = 0;
#pragma unroll
        for (int d0 = 0; d0 < 8; ++d0) QL(qr[d0]);
#pragma unroll
        for (int d0 = 0; d0 < 8; ++d0) { float v[8]; q_unpack(qr[d0], v); q_scale(v, r, g + 16 * d0 + 8 * hi + dep, scale); qr[d0] = q_pack(v); QDEP(dep, qr[d0]); }
    }
};
struct QNormDiff {
    const float *g, *cosd, *sind; float scale;
    __device__ __forceinline__ void operator()(bf16x8* qr, int trow, int hi) const {
        const float r = q_rstd<0, 4>(qr); int dep = 0;
#pragma unroll
        for (int d0 = 0; d0 < 4; ++d0) QL(qr[d0]);
#pragma unroll
        for (int d0 = 0; d0 < 4; ++d0) { float v[8]; q_unpack(qr[d0], v); q_scale(v, r, g + 16 * d0 + 8 * hi + dep, scale);
            if (d0 == 0) { const f32x4 c0 = *(const f32x4*)(cosd + trow * 8), c1 = *(const f32x4*)(cosd + trow * 8 + 4), s0 = *(const f32x4*)(sind + trow * 8), s1 = *(const f32x4*)(sind + trow * 8 + 4);
#pragma unroll
                for (int e = 0; e < 8; ++e) { const float c = e < 4 ? c0[e & 3] : c1[e & 3], sn = e < 4 ? s0[e & 3] : s1[e & 3];
                    auto rr = __builtin_amdgcn_permlane32_swap(__float_as_uint(v[e]), __float_as_uint(v[e]), false, false);
                    const float p = __uint_as_float(hi ? rr[0] : rr[1]);
                    v[e] = hi ? (p * sn + v[e] * c) : (v[e] * c - p * sn); } }
            qr[d0] = q_pack(v); QDEP(dep, qr[d0]); }
    }
};
struct QNormMLA {
    const float *gn, *gp, *cosm, *sinm; float scale;
    __device__ __forceinline__ void operator()(bf16x8* qr, int trow, int hi) const {
        const float ra = q_rstd<0, 8>(qr), rb = q_rstd<8, 12>(qr); int dep = 0;
#pragma unroll
        for (int d0 = 0; d0 < 12; ++d0) QL(qr[d0]);
#pragma unroll
        for (int d0 = 0; d0 < 8; ++d0) { float v[8]; q_unpack(qr[d0], v); q_scale(v, ra, gn + 16 * d0 + 8 * hi + dep, scale); qr[d0] = q_pack(v); QDEP(dep, qr[d0]); }
#pragma unroll
        for (int k = 0; k < 2; ++k) { float a[8], b[8]; q_unpack(qr[8 + k], a); q_unpack(qr[10 + k], b);
            q_scale(a, rb, gp + 16 * k + 8 * hi + dep, scale); q_scale(b, rb, gp + 32 + 16 * k + 8 * hi + dep, scale);
            const float* cp = cosm + trow * 32 + 16 * k + 8 * hi + dep; const float* sp = sinm + trow * 32 + 16 * k + 8 * hi + dep;
            const f32x4 c0 = *(const f32x4*)cp, c1 = *(const f32x4*)(cp + 4), s0 = *(const f32x4*)sp, s1 = *(const f32x4*)(sp + 4);
#pragma unroll
            for (int e = 0; e < 8; ++e) { const float c = e < 4 ? c0[e & 3] : c1[e & 3], sn = e < 4 ? s0[e & 3] : s1[e & 3];
                const float x = a[e], y = b[e]; a[e] = x * c - y * sn; b[e] = x * sn + y * c; }
            qr[8 + k] = q_pack(a); qr[10 + k] = q_pack(b); QDEP(dep, qr[10 + k]); }
    }
};
#undef QL
#undef QDEP
struct AttnOut { bf16_t* dst; float* scr; float lam; const float* subln; float post; };

template <int I, int N, class F> __device__ __forceinline__ void static_for(F&& f) { if constexpr (I < N) { f(std::integral_constant<int, I>{}); static_for<I + 1, N>(f); } }
template <int OFF> __device__ __forceinline__ bf16x8 dsr128(unsigned a) { bf16x8 r; asm volatile("ds_read_b128 %0, %1 offset:%2" : "=&v"(r) : "v"(a), "i"(OFF) : "memory"); return r; }
template <int OFF> __device__ __forceinline__ s16x4 dstr(unsigned a) { s16x4 r; asm volatile("ds_read_b64_tr_b16 %0, %1 offset:%2" : "=&v"(r) : "v"(a), "i"(OFF) : "memory"); return r; }
template <int N> __device__ __forceinline__ void lgk_wait() { asm volatile("s_waitcnt lgkmcnt(%0)" :: "i"(N) : "memory"); }
template <int NQK, bool DO_QK, bool DO_PV, bool PRE>
__device__ __forceinline__ void mseg(f32x16& S0, f32x16& S1, f32x16* o, const KB<NQK>& kb, int kbufoff, const bf16x8* qr, unsigned vb, bf16x8 pa0, bf16x8 pa1, bf16x8 pa2, bf16x8 pa3, bf16x8 (&kfa)[4]) {
    constexpr int NB = KB<NQK>::NB, NG = NQK / 2, RB = NQK * 32;
    constexpr int NKS = DO_QK ? NG : 0, NVS = DO_PV ? 4 : 0, NST = NKS + NVS;
    bf16x8 kfb[4], kfc[4]; s16x4 vf[3][8];
    unsigned ka[NB];
    if constexpr (DO_QK) {
#pragma unroll
        for (int k = 0; k < NB; ++k) ka[k] = kb.a[k] + (unsigned)kbufoff;
        S0 = f32x16{}; S1 = f32x16{};
    }
    auto issue = [&](auto st) {
        constexpr int ST = decltype(st)::value;
        if constexpr (ST < NKS) {
            constexpr int G = ST, SET = G % 3;
            static_for<0, 2>([&](auto s_) { constexpr int D0 = 2 * G + decltype(s_)::value, SS = decltype(s_)::value;
                const bf16x8 r0 = dsr128<(D0 / NB) * 128>(ka[D0 % NB]), r1 = dsr128<(D0 / NB) * 128 + 32 * RB>(ka[D0 % NB]);
                if constexpr (SET == 0) { kfa[2 * SS] = r0; kfa[2 * SS + 1] = r1; } else if constexpr (SET == 1) { kfb[2 * SS] = r0; kfb[2 * SS + 1] = r1; } else { kfc[2 * SS] = r0; kfc[2 * SS + 1] = r1; } });
        } else {
            constexpr int D0 = ST - NKS, SET = D0 % 3;
            static_for<0, 4>([&](auto ks_) { constexpr int KS = decltype(ks_)::value;
                vf[SET][2 * KS] = dstr<v_rd_off(D0, KS, 0)>(vb); vf[SET][2 * KS + 1] = dstr<v_rd_off(D0, KS, 1)>(vb); });
        }
    };
#define STCNT(st) (((st) >= NST) ? 0 : ((st) < NKS ? 4 : 8))
    if constexpr (!(PRE && DO_QK)) issue(std::integral_constant<int, 0>{});
    if constexpr (NST > 1) issue(std::integral_constant<int, 1>{});
    static_for<0, NST>([&](auto st) {
        constexpr int ST = decltype(st)::value;
        if constexpr (ST + 2 < NST) issue(std::integral_constant<int, ST + 2>{});
        { constexpr int AHEAD = STCNT(ST + 1) + STCNT(ST + 2); lgk_wait<(AHEAD > 15 ? 15 : AHEAD)>(); }
        SBAR();
        if constexpr (ST < NKS) {
            constexpr int G = ST, SET = G % 3;
            static_for<0, 2>([&](auto s_) { constexpr int SS = decltype(s_)::value;
                if constexpr (SET == 0) { S0 = __builtin_amdgcn_mfma_f32_32x32x16_bf16(kfa[2 * SS], qr[2 * G + SS], S0, 0, 0, 0); S1 = __builtin_amdgcn_mfma_f32_32x32x16_bf16(kfa[2 * SS + 1], qr[2 * G + SS], S1, 0, 0, 0); }
                else if constexpr (SET == 1) { S0 = __builtin_amdgcn_mfma_f32_32x32x16_bf16(kfb[2 * SS], qr[2 * G + SS], S0, 0, 0, 0); S1 = __builtin_amdgcn_mfma_f32_32x32x16_bf16(kfb[2 * SS + 1], qr[2 * G + SS], S1, 0, 0, 0); }
                else { S0 = __builtin_amdgcn_mfma_f32_32x32x16_bf16(kfc[2 * SS], qr[2 * G + SS], S0, 0, 0, 0); S1 = __builtin_amdgcn_mfma_f32_32x32x16_bf16(kfc[2 * SS + 1], qr[2 * G + SS], S1, 0, 0, 0); } });
        } else {
            constexpr int D0 = ST - NKS, SET = D0 % 3;
#define VPK(ks) (bf16x8){vf[SET][2 * (ks)][0], vf[SET][2 * (ks)][1], vf[SET][2 * (ks)][2], vf[SET][2 * (ks)][3], vf[SET][2 * (ks) + 1][0], vf[SET][2 * (ks) + 1][1], vf[SET][2 * (ks) + 1][2], vf[SET][2 * (ks) + 1][3]}
            o[D0] = __builtin_amdgcn_mfma_f32_32x32x16_bf16(VPK(0), pa0, o[D0], 0, 0, 0);
            o[D0] = __builtin_amdgcn_mfma_f32_32x32x16_bf16(VPK(1), pa1, o[D0], 0, 0, 0);
            o[D0] = __builtin_amdgcn_mfma_f32_32x32x16_bf16(VPK(2), pa2, o[D0], 0, 0, 0);
            o[D0] = __builtin_amdgcn_mfma_f32_32x32x16_bf16(VPK(3), pa3, o[D0], 0, 0, 0);
#undef VPK
        }
    });
#undef STCNT
}

template <int NQK> __device__ __forceinline__ void kpre(bf16x8 (&kfa)[4], const KB<NQK>& kb, int kbufoff) {
    constexpr int NB = KB<NQK>::NB, RB = NQK * 32;
    static_for<0, 2>([&](auto s_) { constexpr int D0 = decltype(s_)::value; const unsigned ad = kb.a[D0 % NB] + (unsigned)kbufoff;
        kfa[2 * D0] = dsr128<(D0 / NB) * 128>(ad); kfa[2 * D0 + 1] = dsr128<(D0 / NB) * 128 + 32 * RB>(ad); });
}

template <int NQK, int MODE, int ldq, int ldk, int ldv, int LDO, class Hook, class QP>
__device__ __forceinline__ void attn_pp(const bf16_t* __restrict__ Qb, const bf16_t* __restrict__ Kh, const bf16_t* __restrict__ Vh,
                                        int NT, char* lds, const Hook& hook, const AttnOut& out, int wave, const QP& qprep, int t0) {
    constexpr int RB = NQK * 32, KT = 64 * RB, NKP = KT / 4096, NOG = NKP > 4 ? NKP : 4;
    int lane_ = lane_id(); asm volatile("" : "+v"(lane_));
    const int wid = wave, lane = lane_, r32 = lane & 31, hi = lane >> 5, g = wave >> 2, gi = wave & 3;
    char* V_lds = lds + OFF_V; char* K_lds = lds + OFF_K;
    float l_reg = 0; f32x16 o[4] = {}; bf16x8 qr[NQK];
    { const bf16_t* Qw = Qb + (long)(wid * QBLK + r32) * ldq + hi * 8;
#pragma unroll
      for (int d0 = 0; d0 < NQK; ++d0) qr[d0] = *reinterpret_cast<const bf16x8*>(Qw + d0 * 16);
      qprep(qr, t0 + wid * QBLK + r32, hi); }
    unsigned og[NOG];
    if (g == 1) {
#pragma unroll
        for (int i = 0; i < NKP; ++i) { const int off = (gi * NKP + i) * 1024 + lane * 16, row = off / RB, ph = (off % RB) >> 4, f = (NQK == 8) ? (row & 15) : ((row >> 1) & 7);
            og[i] = (unsigned)(row * ldk + (ph ^ f) * 8) * 2u; }
#pragma unroll
        for (int i = NKP; i < NOG; ++i) og[i] = 0u;
    } else {
#pragma unroll
        for (int i = 0; i < 4; ++i) { const int off = (gi * 4 + i) * 1024 + lane * 16, sub = off >> 9, within = (off & 511) >> 1, kk = (sub >> 2) * 8 + (within >> 5), c = (sub & 3) * 32 + (within & 31);
            const int k = kk;
            og[i] = (unsigned)(k * ldv + c) * 2u; }
#pragma unroll
        for (int i = 4; i < NOG; ++i) og[i] = 0u;
    }
    const int vb0 = (int)(uintptr_t)V_lds + v_rd_base(lane);
    KB<NQK> kb; kb_init<NQK>(kb, (unsigned)(uintptr_t)K_lds, r32, hi);
    LAS unsigned char* const kdst = (LAS unsigned char*)(uintptr_t)((unsigned)(uintptr_t)K_lds + (unsigned)(gi * NKP) * 1024u);
    LAS unsigned char* const vdst = (LAS unsigned char*)(uintptr_t)((unsigned)(uintptr_t)V_lds + (unsigned)(gi * 4) * 1024u);
#define DMA_K(t, b) do { const char* kt_ = (const char*)(Kh + (long)(t) * (KVBLK * ldk)); _Pragma("unroll") for (int i_ = 0; i_ < NKP; ++i_) \
    __builtin_amdgcn_global_load_lds((const unsigned*)(kt_ + og[i_]), (LAS unsigned*)(kdst + (b) * KT + i_ * 1024), 16, 0, 0); } while (0)
#define DMA_V(t, b) do { const char* vt_ = (const char*)(Vh + (long)(t) * (KVBLK * ldv)); _Pragma("unroll") for (int i_ = 0; i_ < 4; ++i_) \
    __builtin_amdgcn_global_load_lds((const unsigned*)(vt_ + og[i_]), (LAS unsigned*)(vdst + (b) * SHM_V + i_ * 1024), 16, 0, 0); } while (0)
#define VMW() asm volatile("s_waitcnt vmcnt(0)" ::: "memory")
#define PBAR() do { asm volatile("s_waitcnt lgkmcnt(0)" ::: "memory"); __builtin_amdgcn_s_barrier(); asm volatile("" ::: "memory"); SBAR(); } while (0)
    f32x16 S0, S1; bf16x8 pa0, pa1, pa2, pa3, kfa[4];
    if (g == 0) DMA_V(0, 0); else { DMA_K(0, 0); DMA_K(1, 1); }
    VMW(); PBAR();
    const unsigned vbu = (unsigned)vb0;
    if (g == 0) {
        mseg<NQK, true, false, false>(S0, S1, o, kb, 0, qr, vbu, pa0, pa1, pa2, pa3, kfa); PBAR();
        int vcur = 0, vnext = 1, kn = 1;
        for (int t = 0; t + 1 < NT; ++t) {
            VMW(); DMA_V(t + 1, vnext);
            hook(S0, S1, t, hi); finishSM(S0, S1, l_reg, pa0, pa1, pa2, pa3); kpre<NQK>(kfa, kb, kn * KT); PBAR();
            mseg<NQK, true, true, true>(S0, S1, o, kb, kn * KT, qr, vbu + vcur * SHM_V, pa0, pa1, pa2, pa3, kfa); PBAR();
            vcur = vnext; vnext = (vnext == 2) ? 0 : vnext + 1; kn = (kn == 2) ? 0 : kn + 1;
        }
        VMW(); hook(S0, S1, NT - 1, hi); finishSM(S0, S1, l_reg, pa0, pa1, pa2, pa3); PBAR();
        mseg<NQK, false, true, false>(S0, S1, o, kb, 0, qr, vbu + vcur * SHM_V, pa0, pa1, pa2, pa3, kfa); PBAR();
        PBAR();
    } else {
        if (2 < NT) DMA_K(2, 2); PBAR();
        mseg<NQK, true, false, false>(S0, S1, o, kb, 0, qr, vbu, pa0, pa1, pa2, pa3, kfa); VMW(); PBAR();
        int vcur = 0, kn = 1, kd = 0;
        for (int t = 0; t + 1 < NT; ++t) {
            if (t + 3 < NT) DMA_K(t + 3, kd);
            hook(S0, S1, t, hi); finishSM(S0, S1, l_reg, pa0, pa1, pa2, pa3); kpre<NQK>(kfa, kb, kn * KT); PBAR();
            mseg<NQK, true, true, true>(S0, S1, o, kb, kn * KT, qr, vbu + vcur * SHM_V, pa0, pa1, pa2, pa3, kfa); VMW(); PBAR();
            vcur = (vcur == 2) ? 0 : vcur + 1; kn = (kn == 2) ? 0 : kn + 1; kd = (kd == 2) ? 0 : kd + 1;
        }
        hook(S0, S1, NT - 1, hi); finishSM(S0, S1, l_reg, pa0, pa1, pa2, pa3); PBAR();
        mseg<NQK, false, true, false>(S0, S1, o, kb, 0, qr, vbu + vcur * SHM_V, pa0, pa1, pa2, pa3, kfa); PBAR();
    }
#undef DMA_K
#undef DMA_V
#undef VMW
#undef PBAR
    { auto rr = __builtin_amdgcn_permlane32_swap(__float_as_uint(l_reg), __float_as_uint(l_reg), false, false); l_reg = __uint_as_float(rr[0]) + __uint_as_float(rr[1]); }
    const int lane_e = lane_id(), r32_e = lane_e & 31, hi_e = lane_e >> 5, tid_e = wid * 64 + lane_e;
    const float rl = 1.0f / l_reg;
#define LAUNDER(p) asm volatile("" : "+v"(p))
#define ST8(P, X0, X1, X2, X3, Y0, Y1, Y2, Y3) do { const unsigned a0_ = cvt_pk_bf16(X0, X1), a1_ = cvt_pk_bf16(X2, X3), b0_ = cvt_pk_bf16(Y0, Y1), b1_ = cvt_pk_bf16(Y2, Y3);   \
        auto s0_ = __builtin_amdgcn_permlane32_swap(a0_, b0_, false, false); auto s1_ = __builtin_amdgcn_permlane32_swap(a1_, b1_, false, false);                       \
        u32x4 w_ = {s0_[0], s1_[0], s0_[1], s1_[1]}; *(GAS u32x4*)(P) = w_; } while (0)
    if constexpr (MODE == 0) {
        GAS bf16_t* p = (GAS bf16_t*)(out.dst + (long)(wid * QBLK + r32_e) * LDO + 8 * hi_e);
#pragma unroll
        for (int d0 = 0; d0 < 4; ++d0) {
#pragma unroll
            for (int j = 0; j < 2; ++j)
                ST8(p + d0 * 32 + 16 * j, o[d0][8 * j] * rl, o[d0][8 * j + 1] * rl, o[d0][8 * j + 2] * rl, o[d0][8 * j + 3] * rl, o[d0][8 * j + 4] * rl, o[d0][8 * j + 5] * rl, o[d0][8 * j + 6] * rl, o[d0][8 * j + 7] * rl);
        }
    } else if constexpr (MODE == 1) {
        GAS f32x4* sp = (GAS f32x4*)out.scr + tid_e;
#pragma unroll
        for (int d0 = 0; d0 < 4; ++d0) {
#pragma unroll
            for (int q4 = 0; q4 < 4; ++q4) { f32x4 v = {o[d0][4 * q4] * rl, o[d0][4 * q4 + 1] * rl, o[d0][4 * q4 + 2] * rl, o[d0][4 * q4 + 3] * rl}; sp[(d0 * 4 + q4) * 512] = v; }
        }
    } else {
        GAS bf16_t* p = (GAS bf16_t*)(out.dst + (long)(wid * QBLK + r32_e) * LDO + 8 * hi_e);
        const GAS f32x4* sp = (const GAS f32x4*)out.scr + tid_e;
        const float nl = -out.lam * rl;
        float sq = 0.f;
#pragma unroll
        for (int d0 = 0; d0 < 4; ++d0) {
#pragma unroll
            for (int q4 = 0; q4 < 4; ++q4) { const f32x4 c0 = sp[(d0 * 4 + q4) * 512];
#pragma unroll
                for (int e = 0; e < 4; ++e) { const float v = fmaf(nl, o[d0][4 * q4 + e], c0[e]); o[d0][4 * q4 + e] = v; sq = fmaf(v, v, sq); } }
        }
        sq = xor32_sum(sq);
        const float rs = rsqrtf(sq * (1.0f / 128.0f) + EPS) * out.post;
        const GAS f32x4* gp = (const GAS f32x4*)(out.subln + 4 * hi_e);
#pragma unroll
        for (int d0 = 0; d0 < 4; ++d0) {
#pragma unroll
            for (int j = 0; j < 2; ++j) { const f32x4 g0 = gp[d0 * 8 + 4 * j], g1 = gp[d0 * 8 + 4 * j + 2];
                ST8(p + d0 * 32 + 16 * j, o[d0][8 * j] * rs * g0[0], o[d0][8 * j + 1] * rs * g0[1], o[d0][8 * j + 2] * rs * g0[2], o[d0][8 * j + 3] * rs * g0[3],
                    o[d0][8 * j + 4] * rs * g1[0], o[d0][8 * j + 5] * rs * g1[1], o[d0][8 * j + 6] * rs * g1[2], o[d0][8 * j + 7] * rs * g1[3]); }
        }
    }
#undef ST8
#undef LAUNDER
}
#undef SBAR
}

constexpr size_t MiB = 1u << 20;
constexpr size_t WS_CTL = 0, CTL_ZERO_BYTES = 1 * MiB;
constexpr size_t WS_COSM = 1 * MiB, WS_SINM = 3 * MiB, WS_COSD = 5 * MiB, WS_SIND = 5 * MiB + 512 * 1024;
constexpr size_t WS_SSA = 8 * MiB, WS_SSB = 11 * MiB, WS_SSQ = 14 * MiB;
constexpr size_t WS_WIN = 16 * MiB, WS_WQB = 36 * MiB, WS_WKVB = 37 * MiB, WS_WOUT = 38 * MiB, WS_WGU = 46 * MiB, WS_WDN = 90 * MiB, WS_WPG = 112 * MiB, WS_WPP = 120 * MiB, WS_PB = 121 * MiB;
constexpr size_t WS_XB = 134 * MiB;
constexpr size_t WS_BIG = 230 * MiB;
constexpr size_t WS_PROJ = WS_BIG, WS_QM = WS_BIG + 240 * MiB, WS_KVM = WS_BIG + 288 * MiB, WS_KF = WS_BIG + 348 * MiB, WS_MIX = WS_BIG + 393 * MiB, WS_DSCR = WS_BIG + 489 * MiB;
constexpr size_t WS_GSCR = WS_BIG, WS_EDGE = WS_BIG + 16 * MiB, WS_PP = WS_BIG + 32 * MiB, WS_ACT = WS_BIG + 128 * MiB;
constexpr size_t WS_XB2 = WS_BIG + 521 * MiB;
constexpr size_t WS_W2 = WS_XB2 + 96 * MiB;
constexpr size_t WS_END = WS_W2 + (WS_XB - WS_WIN);
static_assert(WS_WQB >= WS_WIN + (size_t)NPROJ_P * DM * 2 && WS_WGU + (size_t)LD_GU * DM * 2 <= WS_WDN && WS_WDN + (size_t)DM * DFF * 2 <= WS_WPG && WS_PB + (size_t)MROWS * PLE * 2 <= WS_XB, "ws map");
static_assert(WS_PROJ + (size_t)MROWS * NPROJ_P * 2 <= WS_QM && WS_QM + (size_t)MROWS * LD_QM * 2 <= WS_KVM && WS_KVM + (size_t)MROWS * LD_KVM * 2 <= WS_KF && WS_KF + (size_t)MROWS * LD_KF * 2 <= WS_MIX && WS_MIX + (size_t)MROWS * DM * 2 <= WS_DSCR && WS_DSCR + (size_t)32 * MiB <= WS_XB2 && WS_ACT + (size_t)MROWS * DFF * 2 <= WS_MIX, "ws map 2");
static_assert(WS_EDGE + (size_t)6 * 96 * DFF * 4 <= WS_PP && WS_PP + (size_t)MROWS * DM * 2 <= WS_ACT && WS_ACT + (size_t)MROWS * DFF * 2 <= WS_XB2, "ws map 3");

constexpr int CW_BAR = 4096, CW_Q = 16384;

constexpr int NWAVES = 8;
constexpr int RING_OFF = 0, RING_BYTES = 131072;
constexpr int LDSCTL_OFF = RING_BYTES, MISC_OFF = LDSCTL_OFF + 320, BIAS_OFF = LDSCTL_OFF + 1024;
constexpr int XLDS_OFF = LDSCTL_OFF + 4096;
constexpr int LDS_BYTES = 147456;
static_assert(BIAS_OFF + 704 * 4 <= LDS_BYTES && att::ATT_LDS <= RING_BYTES, "LDS map");

#define RLX_AGENT __ATOMIC_RELAXED, __HIP_MEMORY_SCOPE_AGENT

#define XB_TMO      128
#define XB_XCNT(j)  (256  + 64 * (j))
#define XB_XSUB(j)  (1280 + 64 * (j))
#define XB_XGEN(j)  (2304 + 64 * (j))
#define XB_TOP      3328
#define XB_TOPGEN   3392
#define XCD_BAR_WORDS 3456
#define XB_SPIN_CAP (1u << 18)
__device__ __forceinline__ unsigned xb_ld(unsigned* p)              { return __hip_atomic_load(p, __ATOMIC_RELAXED, __HIP_MEMORY_SCOPE_AGENT); }
__device__ __forceinline__ unsigned xb_add(unsigned* p, unsigned v) { return __hip_atomic_fetch_add(p, v, __ATOMIC_RELAXED, __HIP_MEMORY_SCOPE_AGENT); }
__device__ __forceinline__ unsigned xb_xcc_id() { return (unsigned)__builtin_amdgcn_s_getreg((3 << 11) | 20) & 0xFu; }
#define XB_SPIN(cond, bar) do { unsigned _sp = 0; while (cond) { __builtin_amdgcn_s_sleep(1); \
    if ((++_sp & 255u) == 0u) { if (xb_ld(&(bar)[XB_TMO])) break; if (_sp > XB_SPIN_CAP) { atomicAdd(&(bar)[XB_TMO], 1u); break; } } } } while (0)
struct XcdBarrier { unsigned* bar; unsigned x; volatile LAS unsigned* st; int wave; };
__device__ __forceinline__ XcdBarrier xcd_barrier_post(unsigned* bar, volatile LAS unsigned* st) {
    XcdBarrier b; b.bar = bar; b.x = xb_xcc_id(); b.st = st; b.wave = 0;
    if (threadIdx.x == 0) (void)xb_add(&bar[XB_XCNT(b.x)], 1u);
    return b;
}
__device__ __forceinline__ void xcd_barrier_complete(unsigned* bar, unsigned x, unsigned& nloc, unsigned& nx) {
    const unsigned G = gridDim.x * gridDim.y * gridDim.z;
    unsigned sum, cnt, mine, sp = 0u;
    for (;;) {
        sum = 0u; cnt = 0u; mine = 0u;
#pragma unroll
        for (unsigned j = 0; j < 16; ++j) { const unsigned c = xb_ld(&bar[XB_XCNT(j)]); sum += c; cnt += (c > 0u) ? 1u : 0u; mine = (j == x) ? c : mine; }
        if (sum == G) break;
        __builtin_amdgcn_s_sleep(1);
        if ((++sp & 255u) == 0u) { if (xb_ld(&bar[XB_TMO])) break; if (sp > XB_SPIN_CAP) { atomicAdd(&bar[XB_TMO], 1u); break; } }
    }
    nloc = mine > 0u ? mine : 1u; nx = cnt > 0u ? cnt : 1u;
}
__device__ __forceinline__ void xcd_barrier(const XcdBarrier& b) {
    asm volatile("s_waitcnt vmcnt(0)" ::: "memory");
    __syncthreads();
    if (b.wave == 0 && lane_id() == 0) {
        unsigned* bar = b.bar;
        __builtin_amdgcn_s_waitcnt(0);
        unsigned nloc = b.st[0], nx = b.st[1];
        if (nloc == 0u) { xcd_barrier_complete(bar, b.x, nloc, nx); b.st[0] = nloc; b.st[1] = nx; }
        const unsigned old = xb_add(&bar[XB_XSUB(b.x)], 1u);
        const unsigned gen = old / nloc;
        if (old + 1u == (gen + 1u) * nloc) {
            __builtin_amdgcn_fence(__ATOMIC_RELEASE, "agent");
            asm volatile("s_waitcnt vmcnt(0)" ::: "memory");
            const unsigned og = xb_add(&bar[XB_TOP], 1u);
            const unsigned tg = og / nx;
            if (og + 1u == (tg + 1u) * nx) xb_add(&bar[XB_TOPGEN], 1u);
            else XB_SPIN(xb_ld(&bar[XB_TOPGEN]) == tg, bar);
            __builtin_amdgcn_fence(__ATOMIC_ACQUIRE, "agent");
            xb_add(&bar[XB_XGEN(b.x)], 1u);
            asm volatile("s_waitcnt vmcnt(0)" ::: "memory");
        } else {
            XB_SPIN(xb_ld(&bar[XB_XGEN(b.x)]) == gen, bar);
            __builtin_amdgcn_fence(__ATOMIC_ACQUIRE, "agent");
            asm volatile("s_waitcnt vmcnt(0)" ::: "memory");
        }
    }
    __syncthreads();
}

struct Args {
    const float* in[34]; float* out; unsigned char* ws;
    float inv_m[32]; float inv_d[8]; float lam_init[4];
    int ph_lo, ph_hi;
};

struct Frame {
    LAS unsigned char* lds; volatile LAS unsigned* MISC; unsigned* ctl;
    int wave, vcu, G;
};

__device__ __forceinline__ int seq_pos(int row) { return row < SEQ_P ? row : ((row - SEQ_P) & (SEQ_S - 1)); }

__device__ __forceinline__ void transpose_item(const float* W, const float* gain, int K, int N, bf16_t* WT, int row_off, LAS float* scr, int item, int lane, int ilv = 0) {
    const int nblk = N / 32, kb = item / nblk, nb = item % nblk, k0 = 64 * kb, n0 = 32 * nb;
    if (ilv) row_off = (n0 >> 7) * 256 + (n0 & 127) - n0 + (ilv == 2 ? 128 : 0);
    float wv[32];
    { const float* wp = W + (size_t)(k0 + (lane >> 5)) * N + n0 + (lane & 31);
#pragma unroll
      for (int i = 0; i < 32; ++i) wv[i] = wp[(size_t)(2 * i) * N]; }
    { const float g0 = gain ? gain[k0 + (lane & 31) * 2] : 1.f, g1 = gain ? gain[k0 + (lane & 31) * 2 + 1] : 1.f;
#pragma unroll
      for (int i = 0; i < 32; ++i) { const float ga = __int_as_float(__builtin_amdgcn_readlane(__float_as_int(g0), i)), gb = __int_as_float(__builtin_amdgcn_readlane(__float_as_int(g1), i));
          scr[(2 * i + (lane >> 5)) * 33 + (lane & 31)] = wv[i] * ((lane >> 5) ? gb : ga); } }
    asm volatile("s_waitcnt lgkmcnt(0)" ::: "memory");
    const int c = lane & 7;
#pragma unroll
    for (int j = 0; j < 4; ++j) { const int n = (lane >> 3) + 8 * j; const LAS float* s = scr + (8 * c) * 33 + n;
        u32x4 o; o.x = cvt_pk_bf16(s[0 * 33], s[1 * 33]); o.y = cvt_pk_bf16(s[2 * 33], s[3 * 33]); o.z = cvt_pk_bf16(s[4 * 33], s[5 * 33]); o.w = cvt_pk_bf16(s[6 * 33], s[7 * 33]);
        *(u32x4*)(WT + (size_t)(row_off + n0 + n) * K + k0 + 8 * c) = o; }
    asm volatile("s_waitcnt lgkmcnt(0)" ::: "memory");
}

__device__ __forceinline__ void sincos_acc(float ang, float& s, float& c) {
    const double a = (double)ang;
    const double k = rint(a * 0.15915494309189535);
    double rd = fma(-k, 6.283185307179586, a); rd = fma(-k, 2.4492935982947064e-16, rd);
    const float r = (float)rd, r2 = r * r;
    float sp = -1.9572941063391263e-20f;
    sp = fmaf(sp, r2, 8.220635246624329e-18f); sp = fmaf(sp, r2, -2.8114572543455206e-15f); sp = fmaf(sp, r2, 7.647163731819816e-13f); sp = fmaf(sp, r2, -1.6059043836821613e-10f);
    sp = fmaf(sp, r2, 2.505210838544172e-08f); sp = fmaf(sp, r2, -2.7557319223985893e-06f); sp = fmaf(sp, r2, 1.984126984126984e-04f); sp = fmaf(sp, r2, -8.333333333333333e-03f);
    sp = fmaf(sp, r2, 1.6666666666666666e-01f); sp = fmaf(sp, -r2, 1.0f);
    float cp = 8.896791392450574e-22f;
    cp = fmaf(cp, r2, -4.110317623312165e-19f); cp = fmaf(cp, r2, 1.5619206968586225e-16f); cp = fmaf(cp, r2, -4.779477332387385e-14f); cp = fmaf(cp, r2, 1.1470745597729725e-11f);
    cp = fmaf(cp, r2, -2.08767569878681e-09f); cp = fmaf(cp, r2, 2.755731922398589e-07f); cp = fmaf(cp, r2, -2.48015873015873e-05f); cp = fmaf(cp, r2, 1.388888888888889e-03f);
    cp = fmaf(cp, r2, -4.1666666666666664e-02f); cp = fmaf(cp, r2, 0.5f); cp = fmaf(cp, -r2, 1.0f);
    s = sp * r; c = cp;
}

__device__ __forceinline__ float norm64_rope(float v, float gain, int lane, int npair, float c, float s) {
    const float ss = wsum64(v * v);
    v = v * rsqrtf(ss * (1.0f / 64.0f) + EPS) * gain;
    float p;
    if (npair == 32) { auto rr = __builtin_amdgcn_permlane32_swap(__float_as_uint(v), __float_as_uint(v), false, false); p = __uint_as_float(lane < 32 ? rr[1] : rr[0]); }
    else p = dpp_mov<0x128>(v);
    if (lane < 2 * npair) v = (lane < npair) ? (v * c - p * s) : (p * s + v * c);
    return v;
}


constexpr int I_IN = (DM / 64) * (NPROJ / 32), I_QB = (512 / 64) * (960 / 32), I_KVB = (256 / 64) * (1280 / 32), I_OUT = (DM / 64) * (DM / 32), I_G = (DM / 64) * (DFF / 32), I_DN = (DFF / 64) * (DM / 32), I_PP = (PLE / 64) * (DM / 32);
constexpr int NITEMS = I_IN + I_QB + I_KVB + I_OUT + 2 * I_G + I_DN + I_OUT + I_PP;
constexpr int IT_A = I_IN + I_QB + I_KVB + I_OUT, IT_B = IT_A + 2 * I_G;
struct CvtSrc { const float *w_in, *g_mix, *w_qb, *g_cq, *w_kvb, *g_ckv, *w_out, *w_gate, *w_up, *g_ffn, *w_down, *w_pg, *g_ple, *w_pp, *p_p, *p_s; };
__device__ __forceinline__ CvtSrc cvt_src(const Args& a, int LW) {
    CvtSrc c; c.w_in = a.in[5] + (size_t)LW * DM * NPROJ; c.g_mix = a.in[4] + LW * DM; c.w_qb = a.in[10] + (size_t)LW * 512 * 960; c.g_cq = a.in[9] + LW * 512; c.w_kvb = a.in[12] + (size_t)LW * 256 * 1280; c.g_ckv = a.in[11] + LW * 256;
    c.w_out = a.in[24] + (size_t)LW * DM * DM; c.w_gate = a.in[26] + (size_t)LW * DM * DFF; c.w_up = a.in[27] + (size_t)LW * DM * DFF; c.g_ffn = a.in[25] + LW * DM;
    c.w_down = a.in[30] + (size_t)LW * DFF * DM; c.w_pg = a.in[32] + (size_t)LW * DM * DM; c.g_ple = a.in[31] + LW * DM; c.w_pp = a.in[33] + (size_t)LW * PLE * DM;
    c.p_p = a.in[2] + (size_t)LW * SEQ_P * PLE; c.p_s = a.in[3] + (size_t)LW * 2 * SEQ_S * PLE; return c;
}
__device__ __forceinline__ void cvt_item(const CvtSrc c, int it, unsigned char* wbase, LAS float* scr, int lane) {
    int r = it;
    if (r < I_IN) { transpose_item(c.w_in, c.g_mix, DM, NPROJ, (bf16_t*)(wbase + WS_WIN), 0, scr, r, lane); return; } r -= I_IN;
    if (r < I_QB) { transpose_item(c.w_qb, c.g_cq, 512, 960, (bf16_t*)(wbase + WS_WQB), 0, scr, r, lane); return; } r -= I_QB;
    if (r < I_KVB) { transpose_item(c.w_kvb, c.g_ckv, 256, 1280, (bf16_t*)(wbase + WS_WKVB), 0, scr, r, lane); return; } r -= I_KVB;
    if (r < I_OUT) { transpose_item(c.w_out, nullptr, DM, DM, (bf16_t*)(wbase + WS_WOUT), 0, scr, r, lane); return; } r -= I_OUT;
    if (r < I_G) { transpose_item(c.w_gate, c.g_ffn, DM, DFF, (bf16_t*)(wbase + WS_WGU), 0, scr, r, lane, 1); return; } r -= I_G;
    if (r < I_G) { transpose_item(c.w_up, c.g_ffn, DM, DFF, (bf16_t*)(wbase + WS_WGU), 0, scr, r, lane, 2); return; } r -= I_G;
    if (r < I_DN) { transpose_item(c.w_down, nullptr, DFF, DM, (bf16_t*)(wbase + WS_WDN), 0, scr, r, lane); return; } r -= I_DN;
    if (r < I_OUT) { transpose_item(c.w_pg, c.g_ple, DM, DM, (bf16_t*)(wbase + WS_WPG), 0, scr, r, lane); return; } r -= I_OUT;
    transpose_item(c.w_pp, nullptr, PLE, DM, (bf16_t*)(wbase + WS_WPP), 0, scr, r, lane);
}
__device__ __forceinline__ void cvt_prow(const CvtSrc c, int m, unsigned char* wbase, int lane) {
    const float* src = (m < SEQ_P) ? c.p_p + (size_t)m * PLE : c.p_s + (size_t)(m - SEQ_P) * PLE;
    const f32x4 v = ((const f32x4*)src)[lane]; u32x2 w; w.x = cvt_pk_bf16(v[0], v[1]); w.y = cvt_pk_bf16(v[2], v[3]); ((u32x2*)((bf16_t*)(wbase + WS_PB) + (size_t)m * PLE))[lane] = w;
}

__global__ void __launch_bounds__(NWAVES * 64, 2) enc_fwd(Args args) {
    extern __shared__ __attribute__((aligned(16))) unsigned char lds[];
    Frame F;
    F.lds = (LAS unsigned char*)lds;
    F.MISC = (volatile LAS unsigned*)(F.lds + MISC_OFF);
    F.wave = __builtin_amdgcn_readfirstlane((int)threadIdx.x >> 6);
    F.G = gridDim.x; { const int bx = blockIdx.x; F.vcu = (F.G % 8 == 0) ? (bx % 8) * (F.G / 8) + bx / 8 : bx; }
    unsigned char* ws = args.ws;
    F.ctl = (unsigned*)(ws + WS_CTL);
    for (int u = threadIdx.x; u < (LDS_BYTES - LDSCTL_OFF) / 4; u += NWAVES * 64) ((LAS unsigned*)(F.lds + LDSCTL_OFF))[u] = 0u;
    __syncthreads();
#if MK_SPLIT
    XcdBarrier bar; bar.bar = nullptr; bar.x = 0; bar.st = nullptr; bar.wave = 0;
#define GRID_BAR() do { } while (0)
#else
    XcdBarrier bar = xcd_barrier_post(F.ctl + CW_BAR, F.MISC + 8); bar.wave = F.wave;
#define GRID_BAR() xcd_barrier(bar)
#endif
    const int lo = args.ph_lo, hi = args.ph_hi;
#define IN(k) (lo <= (k) && (k) < hi)
#define SEAM(k) do { if (IN((k) + 1)) GRID_BAR(); } while (0)

#define COSM ((float*)(wsl + WS_COSM))
#define SINM ((float*)(wsl + WS_SINM))
#define COSD ((float*)(wsl + WS_COSD))
#define SIND ((float*)(wsl + WS_SIND))
#define SSA ((float*)(wsl + WS_SSA))
#define SSB ((float*)(wsl + WS_SSB))
#define SSQ ((float*)(wsl + WS_SSQ))
#define WIN_L(LW) ((bf16_t*)(wsl + WS_WIN + (((LW) & 1) ? (WS_W2 - WS_WIN) : 0)))
#define WIN WIN_L(L)
#define WQB_L(LW) ((bf16_t*)(wsl + WS_WQB + (((LW) & 1) ? (WS_W2 - WS_WIN) : 0)))
#define WQB WQB_L(L)
#define WKVB_L(LW) ((bf16_t*)(wsl + WS_WKVB + (((LW) & 1) ? (WS_W2 - WS_WIN) : 0)))
#define WKVB WKVB_L(L)
#define WOUT_L(LW) ((bf16_t*)(wsl + WS_WOUT + (((LW) & 1) ? (WS_W2 - WS_WIN) : 0)))
#define WOUT WOUT_L(L)
#define WGU_L(LW) ((bf16_t*)(wsl + WS_WGU + (((LW) & 1) ? (WS_W2 - WS_WIN) : 0)))
#define WGU WGU_L(L)
#define WDN_L(LW) ((bf16_t*)(wsl + WS_WDN + (((LW) & 1) ? (WS_W2 - WS_WIN) : 0)))
#define WDN WDN_L(L)
#define WPG_L(LW) ((bf16_t*)(wsl + WS_WPG + (((LW) & 1) ? (WS_W2 - WS_WIN) : 0)))
#define WPG WPG_L(L)
#define WPP_L(LW) ((bf16_t*)(wsl + WS_WPP + (((LW) & 1) ? (WS_W2 - WS_WIN) : 0)))
#define WPP WPP_L(L)
#define PB_L(LW) ((bf16_t*)(wsl + WS_PB + (((LW) & 1) ? (WS_W2 - WS_WIN) : 0)))
#define PB PB_L(L)
#define XB ((bf16_t*)(wsl + ((L & 1) ? WS_XB2 : WS_XB)))
#define XBN ((bf16_t*)(wsl + ((L & 1) ? WS_XB : WS_XB2)))
#define PROJ ((bf16_t*)(wsl + WS_PROJ))
#define QM ((bf16_t*)(wsl + WS_QM))
#define KVM ((bf16_t*)(wsl + WS_KVM))
#define KF ((bf16_t*)(wsl + WS_KF))
#define MIX ((bf16_t*)(wsl + WS_MIX))
#define DSCR ((float*)(wsl + WS_DSCR))
#define EDGE ((float*)(wsl + WS_EDGE))
#define ACT ((bf16_t*)(wsl + WS_ACT))
#define PP ((bf16_t*)(wsl + WS_PP))
#define PHASE_BEGIN() size_t wso_ = 0; asm volatile("" : "+s"(wso_)); unsigned char* wsl = ws + wso_; int lane = lane_id(); asm volatile("" : "+v"(lane)); const int ptid = F.wave * 64 + lane; (void)lane; (void)ptid; (void)wsl
#define XOUT (args.out)
#define gw (F.vcu * NWAVES + F.wave)
#define NGW (F.G * NWAVES)
#define NGT (F.G * NWAVES * 64)


#define NEXT_UNIT(ctr, uvar) do { if (F.wave == 0 && lane_id() == 0) F.MISC[12] = __hip_atomic_fetch_add((ctr), 1u, RLX_AGENT); __syncthreads(); uvar = __builtin_amdgcn_readfirstlane((int)F.MISC[12]); __syncthreads(); } while (0)
#define CVT_QUEUE(ctr, first, n_items, with_prows, LW) do { \
        constexpr int nch_t_ = ((n_items) + 63) / 64, nch_ = nch_t_ + ((with_prows) ? MROWS / 512 : 0); \
        LAS float* scr_ = (LAS float*)(F.lds + RING_OFF + F.wave * 16384); \
        const CvtSrc cs_ = cvt_src(args, (LW)); unsigned char* wb_ = wsl + ((((LW)) & 1) ? (WS_W2 - WS_WIN) : 0); \
        for (;;) { int c_; NEXT_UNIT((ctr), c_); if (c_ >= nch_) break; \
            const int lane_ = lane_id(); \
            if (c_ < nch_t_) { for (int k_ = 0; k_ < 8; ++k_) { const int it_ = c_ * 64 + F.wave * 8 + k_; if (it_ < (n_items)) cvt_item(cs_, (first) + it_, wb_, scr_, lane_); } } \
            else { for (int k_ = 0; k_ < 64; ++k_) cvt_prow(cs_, (c_ - nch_t_) * 512 + F.wave * 64 + k_, wb_, lane_); } } } while (0)
#define CVT_CTR(L_, k_) (F.ctl + CW_Q + 64 * (48 + 2 * (L_) + (k_)))
    for (int L = 0; L < NLAYER; ++L) {
        const int pb = 11 * L;
        if (PH_ON(0) && IN(pb + 0) && (L == 0 || !CVT_AHEAD)) {
            PHASE_BEGIN();
            for (int rep = 0; rep < NREP(0); ++rep) { if (rep) GRID_BAR();

            LAS float* scr = (LAS float*)(F.lds + RING_OFF + F.wave * 16384);
            { const CvtSrc cs = cvt_src(args, L); unsigned char* wb = wsl + ((L & 1) ? (WS_W2 - WS_WIN) : 0);
              for (int it = gw; it < (CVT_AHEAD ? IT_A : NITEMS); it += NGW) cvt_item(cs, it, wb, scr, lane);
              if (!CVT_AHEAD) for (int m = gw; m < MROWS; m += NGW) cvt_prow(cs, m, wb, lane); }
            if (L == 0) {
                for (int i = F.vcu * (NWAVES * 64) + ptid; i < SEQ_P * 32; i += NGT) { const int t = i >> 5, k = i & 31; float s, c; sincos_acc((float)t * args.inv_m[k], s, c); COSM[i] = c; SINM[i] = s; }
                for (int i = F.vcu * (NWAVES * 64) + ptid; i < SEQ_P * 8; i += NGT) { const int t = i >> 3, k = i & 7; float s, c; sincos_acc((float)t * args.inv_d[k], s, c); COSD[i] = c; SIND[i] = s; }
                for (int m = gw; m < MROWS; m += NGW) { const float* src = (m < SEQ_P) ? args.in[0] + (size_t)m * DM : args.in[1] + (size_t)(m - SEQ_P) * DM;
                    float ss = 0.f;
#pragma unroll
                    for (int j = 0; j < 8; ++j) { const f32x4 v = ((const f32x4*)src)[j * 64 + lane]; ss += (v[0] * v[0] + v[1] * v[1]) + (v[2] * v[2] + v[3] * v[3]);
                        u32x2 w; w.x = cvt_pk_bf16(v[0], v[1]); w.y = cvt_pk_bf16(v[2], v[3]); ((u32x2*)(XB + (size_t)m * DM))[j * 64 + lane] = w; }
                    ss = wsum64(ss);
                    if (lane < 32) SSA[(size_t)m * 32 + lane] = (lane == 0) ? ss : 0.f; }
            }
            }
            SEAM(pb + 0);
        }
        if (PH_ON(1) && IN(pb + 1)) {
            PHASE_BEGIN();
            for (int rep = 0; rep < NREP(1); ++rep) { if (rep) GRID_BAR();

            pg8::Gemm g{XB, WIN, MROWS, NPROJ_P, DM, DM}; pg8::StaticOrder S; S.init(MROWS, NPROJ_P, F.G, (int)blockIdx.x);
            pg8::EpiScaleBf16<true> E{PROJ, NPROJ_P, SSA, SSQ};
            pg8::gemm_phase(F.lds + RING_OFF, g, S, E, F.wave);
            }
            if (CVT_AHEAD && NREP(1) == 1) { PHASE_BEGIN(); CVT_QUEUE(CVT_CTR(L, 0), IT_A, IT_B - IT_A, false, L); }
            SEAM(pb + 1);
        }
        if (PH_ON(2) && IN(pb + 2)) {
            PHASE_BEGIN();
            { const float* g_nak = args.in[7] + L * 128; const float* g_kpe = args.in[16] + L * 64; const float* g_dk = args.in[18] + L * 64;
            for (int m2 = gw * 2; m2 < MROWS; m2 += NGW * 2) {
                unsigned wna[2][6]; bf16_t wdf[2][10], wkpe[2]; float cm[2], sm[2], cd[2], sd[2];
#pragma unroll
                for (int rr = 0; rr < 2; ++rr) { const int m = m2 + rr; const bf16_t* pr = PROJ + (size_t)m * NPROJ_P; const int t = seq_pos(m);
#pragma unroll
                    for (int s = 0; s < 6; ++s) wna[rr][s] = ((const unsigned*)(pr + C_NAK + s * 128))[lane];
                    wkpe[rr] = pr[C_KPE + lane];
#pragma unroll
                    for (int s = 0; s < 10; ++s) wdf[rr][s] = pr[C_DFK + s * 64 + lane];
                    cm[rr] = COSM[t * 32 + (lane & 31)]; sm[rr] = SINM[t * 32 + (lane & 31)]; cd[rr] = COSD[t * 8 + (lane & 7)]; sd[rr] = SIND[t * 8 + (lane & 7)]; }
                const f32x2 gk = ((const f32x2*)g_nak)[lane]; const float gkp = g_kpe[lane], gdk = g_dk[lane];
                asm volatile("" ::: "memory");
#pragma unroll
                for (int rr = 0; rr < 2; ++rr) {
#pragma unroll
                    for (int s = 0; s < 6; ++s) { const float a = bf_lo(wna[rr][s]), b = bf_hi(wna[rr][s]);
                        const float r = rsqrtf(wsum64(a * a + b * b) * (1.0f / 128.0f) + EPS);
                        wna[rr][s] = cvt_pk_bf16(a * r * gk[0], b * r * gk[1]); }
                    wkpe[rr] = f2bf(norm64_rope(bf2f(wkpe[rr]), gkp, lane, 32, cm[rr], sm[rr]));
#pragma unroll
                    for (int s = 0; s < 10; ++s) wdf[rr][s] = f2bf(norm64_rope(bf2f(wdf[rr][s]), gdk, lane, 8, cd[rr], sd[rr])); }
                asm volatile("" ::: "memory");
#pragma unroll
                for (int rr = 0; rr < 2; ++rr) { const int m = m2 + rr; bf16_t* pr = PROJ + (size_t)m * NPROJ_P; bf16_t* kf = KF + (size_t)m * LD_KF;
#pragma unroll
                    for (int s = 0; s < 6; ++s) ((unsigned*)(pr + C_NAK + s * 128))[lane] = wna[rr][s];
#pragma unroll
                    for (int h = 0; h < 5; ++h) kf[h * 192 + 128 + lane] = wkpe[rr];
#pragma unroll
                    for (int s = 0; s < 10; ++s) pr[C_DFK + s * 64 + lane] = wdf[rr][s]; }
            } }
            asm volatile("s_waitcnt vmcnt(0) lgkmcnt(0)" ::: "memory"); __syncthreads();
            int kq = 512, kkv = 256; asm volatile("" : "+s"(kq), "+s"(kkv));
            { PHASE_BEGIN(); pg8::Gemm g{PROJ + C_CQ, WQB, MROWS, 1024, kq, NPROJ_P}; pg8::StaticOrder S; S.init(MROWS, 1024, F.G, (int)blockIdx.x);
              pg8::EpiScaleLat<8, 512> E{QM, LD_QM, SSQ}; pg8::gemm_phase(F.lds + RING_OFF, g, S, E, F.wave); }
            { PHASE_BEGIN(); pg8::Gemm g{PROJ + C_CKV, WKVB, MROWS, 1280, kkv, NPROJ_P}; pg8::StaticOrder S; S.init(MROWS, 1280, F.G, (int)blockIdx.x);
              pg8::EpiKvm E{KVM, KF, SSQ + 8, args.in[15] + L * 128, (LAS float*)(F.lds + XLDS_OFF)}; pg8::gemm_phase(F.lds + RING_OFF, g, S, E, F.wave); }
            SEAM(pb + 4);
        }
        if (PH_ON(5) && IN(pb + 5)) {
            PHASE_BEGIN();
            for (int rep = 0; rep < NREP(5); ++rep) { if (rep) GRID_BAR();

            char* alds = (char*)lds + RING_OFF;
            unsigned* qctr = F.ctl + CW_Q + 64 * (L * 6) + rep * 64 * 24;
#pragma unroll 1
            for (int pass = 0; pass < 2; ++pass) {
            const int ubase = pass ? 320 : 0, ucnt = pass ? 160 : 320;
            if (PH_ON(11)) {
                float lam;
                { const int lane = lane_id(); const float a = wsum64((args.in[19] + L * 64)[lane] * (args.in[20] + L * 64)[lane]); const float b = wsum64((args.in[21] + L * 64)[lane] * (args.in[22] + L * 64)[lane]);
                  lam = expf(a) - expf(b) + args.lam_init[L]; }
                float* scr = DSCR + (size_t)blockIdx.x * (64 * 512);
                for (;;) {
                    int u; NEXT_UNIT(qctr + 64 * (2 * pass), u); if (u >= ucnt) break; u += ubase;
                    int h, row0, kbase, nkeys;
                    if (u < 320) { h = u / 64; row0 = (u % 64) * 256; kbase = 0; nkeys = SEQ_P; }
                    else { const int v = u - 320; h = v / 32; const int w = v % 32; kbase = SEQ_P + (w / 16) * SEQ_S; row0 = kbase + (w % 16) * 256; nkeys = SEQ_S; }
                    att::AttnOut o0{nullptr, scr, 0.f, nullptr, 0.f};
                    const att::QNormDiff qn{args.in[17] + L * 64, COSD, SIND, 0.18033688011112042f  };
                    att::attn_pp<4, 1, NPROJ_P, NPROJ_P, NPROJ_P, DM, att::NoHook>(PROJ + (size_t)row0 * NPROJ_P + C_DFQ + h * 128, PROJ + (size_t)kbase * NPROJ_P + C_DFK + h * 128,
                                                         PROJ + (size_t)kbase * NPROJ_P + C_DFV + h * 128, nkeys / 64, alds, att::NoHook{}, o0, F.wave, qn, row0 - kbase);
                    att::AttnOut o1{MIX + (size_t)row0 * DM + 1408 + h * 128, scr, lam, args.in[23] + L * 128, 1.0f - args.lam_init[L]};
                    att::attn_pp<4, 2, NPROJ_P, NPROJ_P, NPROJ_P, DM, att::NoHook>(PROJ + (size_t)row0 * NPROJ_P + C_DFQ + h * 128 + 64, PROJ + (size_t)kbase * NPROJ_P + C_DFK + h * 128 + 64,
                                                         PROJ + (size_t)kbase * NPROJ_P + C_DFV + h * 128, nkeys / 64, alds, att::NoHook{}, o1, F.wave, qn, row0 - kbase);
                }
            }
            if (PH_ON(12)) for (;;) {
                int u; NEXT_UNIT(qctr + 64 * (2 * pass + 1), u); if (u >= ucnt) break; u += ubase;
                int h, row0, kbase, nkeys;
                if (u < 320) { h = u / 64; row0 = (u % 64) * 256; kbase = 0; nkeys = SEQ_P; }
                else { const int v = u - 320; h = v / 32; const int w = v % 32; kbase = SEQ_P + (w / 16) * SEQ_S; row0 = kbase + (w % 16) * 256; nkeys = SEQ_S; }
                att::AttnOut o0{MIX + (size_t)row0 * DM + 768 + h * 128, nullptr, 0.f, nullptr, 0.f};
                att::attn_pp<12, 0, LD_QM, LD_KF, LD_KVM, DM, att::NoHook>(QM + (size_t)row0 * LD_QM + h * 192, KF + (size_t)kbase * LD_KF + h * 192,
                                                      KVM + (size_t)kbase * LD_KVM + h * 256 + 128, nkeys / 64, alds, att::NoHook{}, o0, F.wave,
                                                      att::QNormMLA{args.in[13] + L * 128, args.in[14] + L * 64, COSM, SINM, 0.10411754627697264f  }, row0 - kbase);
            }
            }
            if (PH_ON(13)) for (;;) {
                int u; NEXT_UNIT(qctr + 64 * 4, u); if (u >= 576) break;
                int h, sbase, rows, r0;
                if (u < 384) { h = u / 64; sbase = 0; rows = 256; r0 = (u % 64) * 4; }
                else { const int v = u - 384; h = v / 32; const int w = v % 32; sbase = SEQ_P + (w / 16) * SEQ_S; rows = 64; r0 = (w % 16) * 4; }
                LAS float* btab = (LAS float*)(F.lds + BIAS_OFF);
                const int lane = lane_id();
                { const int ptid = F.wave * 64 + lane; const float* rpb = args.in[8] + (size_t)(L * 6 + h) * 465; if (ptid < 465) btab[48 + ptid] = rpb[ptid]; }
                int kr_lo = r0 - 4; kr_lo = kr_lo < 0 ? 0 : (kr_lo > rows - 11 ? rows - 11 : kr_lo);
                att::NaHook hook; hook.bias = (const LAS float*)(F.lds + BIAS_OFF) + 48; hook.kr_lo = kr_lo; hook.rq = r0 + (F.wave >> 1);
                { int rs = hook.rq - 4; rs = rs < 0 ? 0 : (rs > rows - 8 ? rows - 8 : rs); hook.rs = rs; }
                hook.c = 32 * (F.wave & 1) + (lane & 31); { int cs = hook.c - 8; cs = cs < 0 ? 0 : (cs > 48 ? 48 : cs); hook.cs = cs; }
                const size_t row0 = (size_t)sbase + (size_t)r0 * 64, krow0 = (size_t)sbase + (size_t)kr_lo * 64;
                att::AttnOut o0{MIX + row0 * DM + h * 128, nullptr, 0.f, nullptr, 0.f};
                att::attn_pp<8, 0, NPROJ_P, NPROJ_P, NPROJ_P, DM, att::NaHook>(PROJ + row0 * NPROJ_P + C_NAQ + h * 128, PROJ + krow0 * NPROJ_P + C_NAK + h * 128,
                                                     PROJ + krow0 * NPROJ_P + C_NAV + h * 128, 11, alds, hook, o0, F.wave, att::QNormNA{args.in[6] + L * 128, 0.12751743082459868f  }, 0);
            }
            if (CVT_AHEAD && L + 1 < NLAYER && NREP(5) == 1) CVT_QUEUE(qctr + 64 * 5, 0, IT_A, false, L + 1);
            }
            SEAM(pb + 5);
        }
        if (PH_ON(6) && IN(pb + 6)) {
            PHASE_BEGIN();
            pg8::Gemm g{MIX, WOUT, MROWS, DM, DM, DM}; pg8::StaticOrder S; S.init(MROWS, DM, F.G, (int)blockIdx.x);
            pg8::EpiResidual<false> E; E.xin = XB; E.xout = nullptr; E.xbf = XB; E.ss_out = SSA; E.ss_in = nullptr; E.pp = nullptr;
            pg8::gemm_phase(F.lds + RING_OFF, g, S, E, F.wave);
            SEAM(pb + 6);
        }
        if (PH_ON(7) && IN(pb + 7)) {
            PHASE_BEGIN();
            for (int rep = 0; rep < NREP(7); ++rep) { if (rep) GRID_BAR();

            pg8::Gemm g{XB, WGU, MROWS, LD_GU, DM, DM}; pg8::StaticOrder S; S.init(MROWS, LD_GU, F.G, (int)blockIdx.x);
            pg8::EpiGateUp E{ACT, SSA, args.in[28] + (size_t)L * 3 * DFF, args.in[29] + (size_t)L * DFF, (LAS unsigned*)(F.lds + XLDS_OFF), EDGE};
            pg8::gemm_phase(F.lds + RING_OFF, g, S, E, F.wave);
            }
            if (CVT_AHEAD && NREP(7) == 1) { PHASE_BEGIN(); CVT_QUEUE(CVT_CTR(L, 1), IT_B, NITEMS - IT_B, true, L); }
            SEAM(pb + 7);
        }
        if (PH_ON(8) && IN(pb + 8)) {
            PHASE_BEGIN();
            for (int rep = 0; rep < NREP(8); ++rep) { if (rep) GRID_BAR();

            const float* cw = args.in[28] + (size_t)L * 3 * DFF;
            const float* PF = EDGE; const float* GF = EDGE + 96 * DFF; const float* UF = EDGE + 2 * 96 * DFF; const float* PL = EDGE + 3 * 96 * DFF; const float* GL = EDGE + 4 * 96 * DFF; const float* UL = EDGE + 5 * 96 * DFF;
            for (int i = F.vcu * (NWAVES * 64) + ptid; i < 2 * 96 * (DFF / 4); i += NGT) {
                const int which = i / (96 * (DFF / 4)), j = i % (96 * (DFF / 4)), pm = j / (DFF / 4), c4 = (j % (DFF / 4)) * 4;
                const int row = pm * 256 + (which ? 255 : 0); const int t = seq_pos(row), slen = row < SEQ_P ? SEQ_P : SEQ_S;
                f32x4 pre = *(const f32x4*)((which ? PL : PF) + (size_t)pm * DFF + c4); const f32x4 uu = *(const f32x4*)((which ? UL : UF) + (size_t)pm * DFF + c4);
                if (which == 0 && t > 0) pre += *(const f32x4*)(cw + c4) * *(const f32x4*)(GL + (size_t)(pm - 1) * DFF + c4);
                if (which == 1 && t < slen - 1) pre += *(const f32x4*)(cw + 2 * DFF + c4) * *(const f32x4*)(GF + (size_t)(pm + 1) * DFF + c4);
                float o[4];
#pragma unroll
                for (int e = 0; e < 4; ++e) o[e] = pre[e] * sigm(pre[e]) * uu[e];
                u32x2 w; w.x = cvt_pk_bf16(o[0], o[1]); w.y = cvt_pk_bf16(o[2], o[3]);
                *(u32x2*)(ACT + (size_t)row * DFF + c4) = w;
            }
            }
            SEAM(pb + 8);
        }
        if (PH_ON(9) && IN(pb + 9)) {
            PHASE_BEGIN();
            { pg8::Gemm g{ACT, WDN, MROWS, DM, DFF, DFF}; pg8::StaticOrder S; S.init(MROWS, DM, F.G, (int)blockIdx.x);
              pg8::EpiResidual<false> E; E.xin = XB; E.xout = nullptr; E.xbf = XB; E.ss_out = SSB; E.ss_in = nullptr; E.pp = nullptr;
              pg8::gemm_phase(F.lds + RING_OFF, g, S, E, F.wave); }
            { PHASE_BEGIN(); int kp = PLE; asm volatile("" : "+s"(kp)); pg8::Gemm g{PB, WPP, MROWS, DM, kp, PLE};   pg8::StaticOrder S; S.init(MROWS, DM, F.G, (int)blockIdx.x);
              pg8::EpiScaleBf16<false> E{PP, DM, nullptr}; pg8::gemm_phase(F.lds + RING_OFF, g, S, E, F.wave); }
            SEAM(pb + 9);
        }
        if (PH_ON(10) && IN(pb + 10)) {
            PHASE_BEGIN();
            pg8::Gemm g{XB, WPG, MROWS, DM, DM, DM}; pg8::StaticOrder S; S.init(MROWS, DM, F.G, (int)blockIdx.x);
            pg8::EpiResidual<true> E; E.xin = XB; E.xout = (L == NLAYER - 1) ? XOUT : nullptr; E.xbf = XBN; E.ss_out = SSA; E.ss_in = SSB; E.pp = PP;
            pg8::gemm_phase(F.lds + RING_OFF, g, S, E, F.wave);
            SEAM(pb + 10);
        }
    }
#undef IN
#undef SEAM
#undef GRID_BAR
}

extern "C" void kernel_launch(void* const* d_in, const int* in_sizes, int n_in, void* d_out, int out_size, void* d_ws, size_t ws_size, hipStream_t stream) {
    static int grid = 0;
    if (grid == 0) {
        if (n_in != 34 || out_size != MROWS * DM || ws_size < WS_END) { fprintf(stderr, "kernel_launch: unexpected shapes: n_in %d out %d ws %zu (need %zu)\n", n_in, out_size, ws_size, (size_t)WS_END); grid = -1; return; }
        int dev = 0, cus = 0, per_cu = 0;
        if (hipGetDevice(&dev) != hipSuccess || hipDeviceGetAttribute(&cus, hipDeviceAttributeMultiprocessorCount, dev) != hipSuccess) { grid = -1; return; }
        if (hipFuncSetAttribute((const void*)enc_fwd, hipFuncAttributeMaxDynamicSharedMemorySize, LDS_BYTES) != hipSuccess) { fprintf(stderr, "kernel_launch: hipFuncSetAttribute failed\n"); grid = -1; return; }
        if (hipOccupancyMaxActiveBlocksPerMultiprocessor(&per_cu, (const void*)enc_fwd, NWAVES * 64, LDS_BYTES) != hipSuccess || per_cu < 1)
            fprintf(stderr, "kernel_launch: occupancy query reports %d workgroups per CU\n", per_cu);
        (void)hipGetLastError();
        grid = cus;
    }
    if (grid < 0) return;
    if (hipMemsetAsync((char*)d_ws + WS_CTL, 0, CTL_ZERO_BYTES, stream) != hipSuccess) { fprintf(stderr, "kernel_launch: memset failed\n"); return; }
    Args a{};
    for (int i = 0; i < 34; ++i) a.in[i] = (const float*)d_in[i];
    a.out = (float*)d_out; a.ws = (unsigned char*)d_ws;
    for (int i = 0; i < 32; ++i) { const float e = (float)(2 * i) / 64.0f; const float p = powf(10000.0f, e); a.inv_m[i] = 1.0f / p; }
    for (int i = 0; i < 8; ++i) { const float e = (float)(2 * i) / 16.0f; const float p = powf(500000.0f, e); a.inv_d[i] = 1.0f / p; }
    for (int i = 0; i < 4; ++i) a.lam_init[i] = (float)(0.8 - 0.6 * exp(-0.3 * (double)i));
#if MK_SPLIT
    for (int p = 0; p < 44; ++p) { a.ph_lo = p; a.ph_hi = p + 1; hipLaunchKernelGGL(enc_fwd, dim3(grid), dim3(NWAVES * 64), LDS_BYTES, stream, a); }
#else
    a.ph_lo = 0; a.ph_hi = 44;
    hipLaunchKernelGGL(enc_fwd, dim3(grid), dim3(NWAVES * 64), LDS_BYTES, stream, a);
#endif
    const hipError_t le = hipPeekAtLastError();
    if (le != hipSuccess) fprintf(stderr, "kernel_launch: launch failed: %s\n", hipGetErrorName(le));
}
```
